# Optimizing an MI355X kernel written in HIP

```python
import jax, jax.numpy as jnp
from jax import lax
import numpy as np

D_MODEL = 1024
BATCH = 16
SEQ = 2048
DEPTH = 1

CONV_WIDTH = 1024
CONV_K = 3
N_HEADS = 8
HEAD_DIM = 64
ATTN_WIDTH = N_HEADS * HEAD_DIM
MOBA_BLOCK = 256
MOBA_TOPK = 3
Q_BLOCK = 128
ROPE_THETA = 500000.0
ROPE_DIM = HEAD_DIM // 4
N_BRANCHES = 2
IN_COLS = 3 * CONV_WIDTH + 3 * ATTN_WIDTH + N_BRANCHES * D_MODEL
N_EXPERTS = 256
TOP_K = 8
N_GROUPS = 8
TOPK_GROUPS = 4
EXPERT_DIM = 256
SHARED_DIM = 256
ROUTED_SCALE = 2.5
MOE_BLOCK = 128
MOE_CHUNK = 8
DN_ALPHA = (2 * DEPTH) ** 0.25
DN_BETA = (8 * DEPTH) ** -0.25
LN_EPS = 1e-5

kernel_name = "hybrid_conv_moba_moe_deepnorm"


def layer_norm(x, g, b):
    xf = x.astype(jnp.float32)
    mu = jnp.mean(xf, -1, keepdims=True)
    var = jnp.mean(jnp.square(xf - mu), -1, keepdims=True)
    return ((xf - mu) * lax.rsqrt(var + LN_EPS)).astype(x.dtype) * g + b


def partial_rope(t, pos):
    half = ROPE_DIM // 2
    inv = jnp.power(ROPE_THETA, -jnp.arange(half, dtype=jnp.float32) * 2.0 / ROPE_DIM)
    ang = pos.astype(jnp.float32)[:, None] * inv[None, :]
    cos = jnp.cos(ang).astype(t.dtype)
    sin = jnp.sin(ang).astype(t.dtype)
    t1 = t[..., :half]
    t2 = t[..., half:ROPE_DIM]
    return jnp.concatenate([t1 * cos - t2 * sin, t2 * cos + t1 * sin, t[..., ROPE_DIM:]], axis=-1)


def short_conv_mixer(b_gate, c_gate, v, w_conv):
    u = c_gate * v
    y = lax.conv_general_dilated(
        u, w_conv[:, None, :].astype(u.dtype), window_strides=(1,),
        padding=[(CONV_K - 1, 0)], dimension_numbers=("NWC", "WIO", "NWC"),
        feature_group_count=CONV_WIDTH)
    return b_gate * y


def moba_attention(q, k, v):
    b_, h_, s_, dh = q.shape
    nb = -(-s_ // MOBA_BLOCK)
    s_pad = nb * MOBA_BLOCK
    pad = [(0, 0), (0, 0), (0, s_pad - s_), (0, 0)]
    kp = jnp.pad(k, pad)
    vp = jnp.pad(v, pad)
    n_sel = min(MOBA_TOPK, nb)
    k_mean = jnp.mean(kp.reshape(b_, h_, nb, MOBA_BLOCK, dh).astype(jnp.float32), axis=3)
    gate = jnp.einsum("bhsd,bhnd->bhsn", q.astype(jnp.float32), k_mean)
    own = jnp.arange(s_) // MOBA_BLOCK
    past = jnp.arange(nb)[None, :] < own[:, None]
    gate = jnp.where(past[None, None], gate, -jnp.inf)
    _, sel = lax.top_k(gate, n_sel)
    scale = dh ** -0.5

    def attend_seq(args):
        q_s, kp_s, vp_s, sel_s = args
        kb = kp_s.reshape(h_, nb, MOBA_BLOCK, dh)
        vb = vp_s.reshape(h_, nb, MOBA_BLOCK, dh)

        def attend_qblock(qi):
            start = qi * Q_BLOCK
            qc = lax.dynamic_slice_in_dim(q_s, start, Q_BLOCK, axis=1)
            blk = start // MOBA_BLOCK
            k_own = lax.dynamic_index_in_dim(kb, blk, axis=1, keepdims=False)
            v_own = lax.dynamic_index_in_dim(vb, blk, axis=1, keepdims=False)
            idx = lax.dynamic_slice_in_dim(sel_s, start, Q_BLOCK, axis=1)
            k_sel = jax.vmap(lambda kb_h, i_h: kb_h[i_h])(kb, idx)
            v_sel = jax.vmap(lambda vb_h, i_h: vb_h[i_h])(vb, idx)
            qpos = start + jnp.arange(Q_BLOCK)
            kpos = blk * MOBA_BLOCK + jnp.arange(MOBA_BLOCK)
            s_own = jnp.einsum("hqd,hkd->hqk", qc, k_own).astype(jnp.float32) * scale
            s_own = jnp.where((kpos[None, :] <= qpos[:, None])[None], s_own, -jnp.inf)
            s_sel = jnp.einsum("hqd,hqnkd->hqnk", qc, k_sel).astype(jnp.float32) * scale
            ok = jnp.arange(n_sel) < blk
            s_sel = jnp.where(ok[None, None, :, None], s_sel, -jnp.inf)
            scores = jnp.concatenate([s_own, s_sel.reshape(h_, Q_BLOCK, n_sel * MOBA_BLOCK)], axis=-1)
            p = jax.nn.softmax(scores, axis=-1).astype(vp_s.dtype)
            p_own = p[..., :MOBA_BLOCK]
            p_sel = p[..., MOBA_BLOCK:].reshape(h_, Q_BLOCK, n_sel, MOBA_BLOCK)
            return (jnp.einsum("hqk,hkd->hqd", p_own, v_own)
                    + jnp.einsum("hqnk,hqnkd->hqd", p_sel, v_sel))

        o = lax.map(attend_qblock, jnp.arange(s_ // Q_BLOCK))
        return jnp.transpose(o, (1, 0, 2, 3)).reshape(h_, s_, dh)

    return lax.map(attend_seq, (q, kp, vp, sel))


def route(x_tok, w_router, router_bias):
    t_ = x_tok.shape[0]
    scores = jax.nn.sigmoid((x_tok @ w_router).astype(jnp.float32))
    biased = scores + router_bias.astype(jnp.float32)
    per_group = N_EXPERTS // N_GROUPS
    grp_score = jnp.sum(lax.top_k(biased.reshape(t_, N_GROUPS, per_group), 2)[0], axis=-1)
    _, grp_idx = lax.top_k(grp_score, TOPK_GROUPS)
    grp_mask = jnp.any(grp_idx[..., None] == jnp.arange(N_GROUPS), axis=-2)
    masked = jnp.where(jnp.repeat(grp_mask, per_group, axis=-1), biased, -jnp.inf)
    _, top_idx = lax.top_k(masked, TOP_K)
    w = jnp.take_along_axis(scores, top_idx, axis=-1)
    w = w / jnp.sum(w, -1, keepdims=True) * ROUTED_SCALE
    return top_idx, w


def routed_experts(x_tok, top_idx, top_w, w1, w3, w2):
    t_, d = x_tok.shape
    a = t_ * TOP_K
    eid = top_idx.reshape(a)
    tok = jnp.repeat(jnp.arange(t_, dtype=jnp.int32), TOP_K)
    wt = top_w.reshape(a)
    order = jnp.argsort(eid)
    e_s = eid[order]
    tok_s = tok[order]
    w_s = wt[order]
    counts = jnp.zeros((N_EXPERTS,), jnp.int32).at[eid].add(1)
    padded = (counts + MOE_BLOCK - 1) // MOE_BLOCK * MOE_BLOCK
    start = jnp.cumsum(counts) - counts
    pend = jnp.cumsum(padded)
    pstart = pend - padded
    rank = jnp.arange(a, dtype=jnp.int32) - start[e_s]
    dest = pstart[e_s] + rank
    step = MOE_BLOCK * MOE_CHUNK
    cap = -(-(a + N_EXPERTS * (MOE_BLOCK - 1)) // step) * step
    src = jnp.full((cap,), t_, jnp.int32).at[dest].set(tok_s)
    w_pad = jnp.zeros((cap,), x_tok.dtype).at[dest].set(w_s.astype(x_tok.dtype))
    x_ext = jnp.concatenate([x_tok, jnp.zeros((1, d), x_tok.dtype)], axis=0)
    x_pad = x_ext[src]
    n_blk = cap // MOE_BLOCK
    blk_exp = jnp.clip(jnp.searchsorted(pend, jnp.arange(n_blk, dtype=jnp.int32) * MOE_BLOCK, side="right"),
                       0, N_EXPERTS - 1)
    xb = x_pad.reshape(cap // step, MOE_CHUNK, MOE_BLOCK, d)
    eb = blk_exp.reshape(cap // step, MOE_CHUNK)

    def run_chunk(args):
        xc, ec = args
        hid = jax.nn.silu(jnp.einsum("gmd,gdf->gmf", xc, w1[ec])) * jnp.einsum("gmd,gdf->gmf", xc, w3[ec])
        return jnp.einsum("gmf,gfd->gmd", hid, w2[ec])

    y_pad = lax.map(run_chunk, (xb, eb)).reshape(cap, d)
    return jax.ops.segment_sum(y_pad * w_pad[:, None], src, num_segments=t_ + 1)[:t_]


def setup_inputs(seed: int = 0) -> dict:
    key = jax.random.key(seed)
    ks = jax.random.split(key, 20)
    L = DEPTH

    def nrm(k, shape, scale):
        return jax.random.normal(k, shape, jnp.float32) * scale

    return {
        "x": nrm(ks[0], (BATCH, SEQ, D_MODEL), 1.0),
        "w_in": nrm(ks[1], (L, D_MODEL, IN_COLS), D_MODEL ** -0.5),
        "b_gate": nrm(ks[2], (L, N_BRANCHES * D_MODEL), 0.02),
        "w_conv": nrm(ks[3], (L, CONV_K, CONV_WIDTH), CONV_K ** -0.5),
        "w_conv_out": nrm(ks[4], (L, CONV_WIDTH, D_MODEL), CONV_WIDTH ** -0.5),
        "w_attn_out": nrm(ks[5], (L, ATTN_WIDTH, D_MODEL), ATTN_WIDTH ** -0.5),
        "w_mix_out": nrm(ks[6], (L, D_MODEL, D_MODEL), D_MODEL ** -0.5 * DN_BETA),
        "ln1_g": 1.0 + nrm(ks[7], (L, D_MODEL), 0.02),
        "ln1_b": nrm(ks[8], (L, D_MODEL), 0.02),
        "w_router": nrm(ks[9], (L, D_MODEL, N_EXPERTS), D_MODEL ** -0.5),
        "router_bias": nrm(ks[10], (L, N_EXPERTS), 0.01),
        "w1": nrm(ks[11], (L, N_EXPERTS, D_MODEL, EXPERT_DIM), D_MODEL ** -0.5),
        "w3": nrm(ks[12], (L, N_EXPERTS, D_MODEL, EXPERT_DIM), D_MODEL ** -0.5),
        "w2": nrm(ks[13], (L, N_EXPERTS, EXPERT_DIM, D_MODEL), EXPERT_DIM ** -0.5 * DN_BETA),
        "ws1": nrm(ks[14], (L, D_MODEL, SHARED_DIM), D_MODEL ** -0.5),
        "ws3": nrm(ks[15], (L, D_MODEL, SHARED_DIM), D_MODEL ** -0.5),
        "ws2": nrm(ks[16], (L, SHARED_DIM, D_MODEL), SHARED_DIM ** -0.5 * DN_BETA),
        "ln2_g": 1.0 + nrm(ks[17], (L, D_MODEL), 0.02),
        "ln2_b": nrm(ks[18], (L, D_MODEL), 0.02),
    }


def reference(x, w_in, b_gate, w_conv, w_conv_out, w_attn_out, w_mix_out, ln1_g, ln1_b,
              w_router, router_bias, w1, w3, w2, ws1, ws3, ws2, ln2_g, ln2_b):
    b_, s_, d = x.shape
    pos = jnp.arange(s_)
    cuts = [CONV_WIDTH, 2 * CONV_WIDTH, 3 * CONV_WIDTH,
            3 * CONV_WIDTH + ATTN_WIDTH, 3 * CONV_WIDTH + 2 * ATTN_WIDTH, 3 * CONV_WIDTH + 3 * ATTN_WIDTH]
    h = x
    for l in range(DEPTH):
        proj = h @ w_in[l]
        cb, cc, cv, q, k, v, g = jnp.split(proj, cuts, axis=-1)
        gates = jax.nn.sigmoid(g + b_gate[l])
        g_conv, g_attn = gates[..., :d], gates[..., d:]
        y_conv = short_conv_mixer(cb, cc, cv, w_conv[l]) @ w_conv_out[l]

        def heads(t):
            return jnp.transpose(t.reshape(b_, s_, N_HEADS, HEAD_DIM), (0, 2, 1, 3))

        qh = partial_rope(heads(q), pos)
        kh = partial_rope(heads(k), pos)
        o = moba_attention(qh, kh, heads(v))
        y_attn = jnp.transpose(o, (0, 2, 1, 3)).reshape(b_, s_, ATTN_WIDTH) @ w_attn_out[l]
        mix = (g_conv * y_conv + g_attn * y_attn) @ w_mix_out[l]
        h = layer_norm(DN_ALPHA * h + mix, ln1_g[l], ln1_b[l])
        t = h.reshape(b_ * s_, d)
        top_idx, top_w = route(t, w_router[l], router_bias[l])
        routed = routed_experts(t, top_idx, top_w, w1[l], w3[l], w2[l])
        shared = (jax.nn.silu(t @ ws1[l]) * (t @ ws3[l])) @ ws2[l]
        h = layer_norm(DN_ALPHA * h + (routed + shared).reshape(b_, s_, d), ln2_g[l], ln2_b[l])
    return h
```

```cpp
#include <hip/hip_runtime.h>
#include <cstdio>
#include <cstdint>

#ifndef MK_SINGLE
#define MK_SINGLE 0
#endif

constexpr int NB = 16, SEQ = 2048, T = NB * SEQ, D = 1024;
constexpr int CW = 1024, NH = 8, HD = 64, AW = 512, MBLK = 256, NBLK = SEQ / MBLK;
constexpr int INC = 3 * CW + 3 * AW + 2 * D;
constexpr int C_CB = 0, C_CC = 1024, C_CV = 2048, C_Q = 3072, C_K = 3584, C_V = 4096, C_GC = 4608, C_GA = 5632;
constexpr int NE = 256, TOPK = 8, NG = 8, TOPG = 4, ED = 256, SD = 256;
constexpr int NA = T * TOPK;
constexpr int NSLOT = NA + T;
constexpr float ALPHA = 1.189207115002721f, LN_EPS = 1e-5f, RSCALE = 2.5f;
constexpr float QSCALE = 0.125f * 1.4426950408889634f;
constexpr int NWAVES = 8, NTHR = 512;

constexpr size_t MiB = 1u << 20;
constexpr size_t WS_CTL = 0, CTL_BYTES = 1 * MiB;
constexpr size_t WS_KMEAN = 1 * MiB;
constexpr size_t WS_WIN = 2 * MiB;
constexpr size_t WS_WCO = 15 * MiB, WS_WAO = 17 * MiB, WS_WMIX = 18 * MiB, WS_WS13 = 20 * MiB, WS_WS2 = 21 * MiB;
constexpr size_t WS_TOPE = 24 * MiB, WS_TOPP = 25 * MiB, WS_TOPW = 26 * MiB;
constexpr size_t WS_H1HI = 28 * MiB, WS_H1LO = 92 * MiB;
constexpr size_t WS_W2T = 156 * MiB;
constexpr size_t WS_HID = 285 * MiB;
constexpr size_t WS_W13T = 429 * MiB;
constexpr size_t WS_BIN = 686 * MiB;
constexpr size_t WS_Y = 429 * MiB;
constexpr size_t WS_XB = 156 * MiB;
constexpr size_t WS_PROJ = 220 * MiB;
constexpr size_t WS_Q = 636 * MiB, WS_K = 668 * MiB, WS_V = 700 * MiB;
constexpr size_t WS_GC = 732 * MiB, WS_GA = 796 * MiB, WS_AC = 860 * MiB;
constexpr size_t WS_O = 924 * MiB;
constexpr size_t WS_MIXED = 956 * MiB;
constexpr size_t WS_END = 1020 * MiB;
constexpr int CW_TMO = 0, CW_CNT = 1024  , CW_BAR = 4096;

typedef unsigned short bf16;
typedef short bf16x8 __attribute__((ext_vector_type(8)));
typedef float f32x4 __attribute__((ext_vector_type(4)));
typedef unsigned u32x4 __attribute__((ext_vector_type(4)));
typedef unsigned u32x2 __attribute__((ext_vector_type(2)));
#define LAS __attribute__((address_space(3)))

__device__ __forceinline__ unsigned f2bf(float f) { unsigned u = __builtin_bit_cast(unsigned, f); return (u + 0x7fffu + ((u >> 16) & 1u)) >> 16; }
__device__ __forceinline__ float bf2f(unsigned h) { return __builtin_bit_cast(float, h << 16); }
__device__ __forceinline__ unsigned pk2(float lo, float hi) { return f2bf(lo) | (f2bf(hi) << 16); }
__device__ __forceinline__ float sigmoidf_(float x) { return 1.0f / (1.0f + __expf(-x)); }
__device__ __forceinline__ float wave_sum(float v) {
#pragma unroll
    for (int o = 1; o < 64; o <<= 1) v += __shfl_xor(v, o);
    return v;
}

struct Frame {
    unsigned char* lds;
    int tid, lane, wave, vcu, G;
    const float* in[19]; float* out; unsigned char* ws;
};

template <class RMap>
__device__ __forceinline__ void transpose_item(const float* W, int K, int N, bf16* WT, RMap rmap, float* scr, int item, int lane) {
    const int nblk = N / 32, kb = item / nblk, nb = item % nblk, k0 = 64 * kb, n0 = 32 * nb;
#pragma unroll 8
    for (int i = 0; i < 32; ++i) { const int kk = 2 * i + (lane >> 5); scr[kk * 33 + (lane & 31)] = W[(size_t)(k0 + kk) * N + n0 + (lane & 31)]; }
    asm volatile("s_waitcnt vmcnt(0) lgkmcnt(0)" ::: "memory");
    const int c = lane & 7;
#pragma unroll
    for (int j = 0; j < 4; ++j) { const int n = (lane >> 3) + 8 * j; const float* s = scr + (8 * c) * 33 + n;
        u32x4 o; o.x = pk2(s[0 * 33], s[1 * 33]); o.y = pk2(s[2 * 33], s[3 * 33]); o.z = pk2(s[4 * 33], s[5 * 33]); o.w = pk2(s[6 * 33], s[7 * 33]);
        *(u32x4*)(WT + (size_t)rmap(n0 + n) * K + k0 + 8 * c) = o; }
    asm volatile("s_waitcnt vmcnt(0) lgkmcnt(0)" ::: "memory");
}
struct RMapId { int off; __device__ __forceinline__ int operator()(int n) const { return off + n; } };
struct RMap13 { int which; __device__ __forceinline__ int operator()(int n) const { return 256 * (n >> 7) + 128 * which + (n & 127); } };

template <bool DUAL, class ARow, class Epi>
__device__ __forceinline__ void sg_tile(ARow arow, const bf16* Bt, const bf16* Bt2, size_t ldb, int K, int wave, int lane, Epi epi) {
    const int wr = wave >> 1, wc = wave & 1, fr = lane & 15, fq = lane >> 4;
    f32x4 acc[2][4], acc2[2][4];
#pragma unroll
    for (int i = 0; i < 2; ++i)
#pragma unroll
        for (int j = 0; j < 4; ++j) { acc[i][j] = (f32x4){0.f, 0.f, 0.f, 0.f}; acc2[i][j] = (f32x4){0.f, 0.f, 0.f, 0.f}; }
    const bf16* ap[2]; const bf16* bp[4]; const bf16* bp2[4];
#pragma unroll
    for (int i = 0; i < 2; ++i) ap[i] = arow(32 * wr + 16 * i + fr) + 8 * fq;
#pragma unroll
    for (int j = 0; j < 4; ++j) { bp[j] = Bt + (size_t)(64 * wc + 16 * j + fr) * ldb + 8 * fq; bp2[j] = DUAL ? Bt2 + (size_t)(64 * wc + 16 * j + fr) * ldb + 8 * fq : bp[j]; }
    for (int k0 = 0; k0 < K; k0 += 32) {
        bf16x8 a[2], b[4], b2[4];
#pragma unroll
        for (int i = 0; i < 2; ++i) a[i] = *(const bf16x8*)(ap[i] + k0);
#pragma unroll
        for (int j = 0; j < 4; ++j) { b[j] = *(const bf16x8*)(bp[j] + k0); if (DUAL) b2[j] = *(const bf16x8*)(bp2[j] + k0); }
#pragma unroll
        for (int i = 0; i < 2; ++i)
#pragma unroll
            for (int j = 0; j < 4; ++j) { acc[i][j] = __builtin_amdgcn_mfma_f32_16x16x32_bf16(a[i], b[j], acc[i][j], 0, 0, 0);
                if (DUAL) acc2[i][j] = __builtin_amdgcn_mfma_f32_16x16x32_bf16(a[i], b2[j], acc2[i][j], 0, 0, 0); }
    }
#pragma unroll
    for (int i = 0; i < 2; ++i)
#pragma unroll
        for (int j = 0; j < 4; ++j)
#pragma unroll
            for (int r = 0; r < 4; ++r) epi(32 * wr + 16 * i + 4 * fq + r, 64 * wc + 16 * j + fr, acc[i][j][r], acc2[i][j][r]);
}

#define XB_TMO      128
#define XB_XCNT(j)  (256  + 64 * (j))
#define XB_XSUB(j)  (1280 + 64 * (j))
#define XB_XGEN(j)  (2304 + 64 * (j))
#define XB_TOP      3328
#define XB_TOPGEN   3392
#define XCD_BAR_WORDS 3456
#define XB_SPIN_CAP (1u << 22)
__device__ __forceinline__ unsigned xb_ld(unsigned* p)              { return __hip_atomic_load(p, __ATOMIC_RELAXED, __HIP_MEMORY_SCOPE_AGENT); }
__device__ __forceinline__ unsigned xb_add(unsigned* p, unsigned v) { return __hip_atomic_fetch_add(p, v, __ATOMIC_RELAXED, __HIP_MEMORY_SCOPE_AGENT); }
__device__ __forceinline__ unsigned xb_xcc_id() { return (unsigned)__builtin_amdgcn_s_getreg((3 << 11) | 20) & 0xFu; }
#define XB_SPIN(cond, bar) do { unsigned _sp = 0; while (cond) { __builtin_amdgcn_s_sleep(1); \
    if ((++_sp & 255u) == 0u) { if (xb_ld(&(bar)[XB_TMO])) break; if (_sp > XB_SPIN_CAP) { atomicAdd(&(bar)[XB_TMO], 1u); break; } } } } while (0)
struct XcdBarrier { unsigned* bar; unsigned x; volatile LAS unsigned* st; };
__device__ __forceinline__ XcdBarrier xcd_barrier_post(unsigned* bar, volatile LAS unsigned* st) {
    XcdBarrier b; b.bar = bar; b.x = xb_xcc_id(); b.st = st;
    if (threadIdx.x == 0) (void)xb_add(&bar[XB_XCNT(b.x)], 1u);
    return b;
}
__device__ __forceinline__ void xcd_barrier_complete(unsigned* bar, unsigned x, unsigned& nloc, unsigned& nx) {
    const unsigned G = gridDim.x * gridDim.y * gridDim.z;
    unsigned sum, cnt, mine, sp = 0u;
    for (;;) {
        sum = 0u; cnt = 0u; mine = 0u;
#pragma unroll
        for (unsigned j = 0; j < 16; ++j) { const unsigned c = xb_ld(&bar[XB_XCNT(j)]); sum += c; cnt += (c > 0u) ? 1u : 0u; mine = (j == x) ? c : mine; }
        if (sum == G) break;
        __builtin_amdgcn_s_sleep(1);
        if ((++sp & 255u) == 0u) { if (xb_ld(&bar[XB_TMO])) break; if (sp > XB_SPIN_CAP) { atomicAdd(&bar[XB_TMO], 1u); break; } }
    }
    nloc = mine > 0u ? mine : 1u; nx = cnt > 0u ? cnt : 1u;
}
__device__ __forceinline__ void xcd_barrier(const XcdBarrier& b) {
    asm volatile("s_waitcnt vmcnt(0)" ::: "memory");
    __syncthreads();
    if (threadIdx.x == 0) {
        unsigned* bar = b.bar;
        __builtin_amdgcn_s_waitcnt(0);
        unsigned nloc = b.st[0], nx = b.st[1];
        if (nloc == 0u) { xcd_barrier_complete(bar, b.x, nloc, nx); b.st[0] = nloc; b.st[1] = nx; }
        const unsigned old = xb_add(&bar[XB_XSUB(b.x)], 1u);
        const unsigned gen = old / nloc;
        if (old + 1u == (gen + 1u) * nloc) {
            __builtin_amdgcn_fence(__ATOMIC_RELEASE, "agent");
            asm volatile("s_waitcnt vmcnt(0)" ::: "memory");
            const unsigned og = xb_add(&bar[XB_TOP], 1u);
            const unsigned tg = og / nx;
            if (og + 1u == (tg + 1u) * nx) xb_add(&bar[XB_TOPGEN], 1u);
            else XB_SPIN(xb_ld(&bar[XB_TOPGEN]) == tg, bar);
            __builtin_amdgcn_fence(__ATOMIC_ACQUIRE, "agent");
            xb_add(&bar[XB_XGEN(b.x)], 1u);
            asm volatile("s_waitcnt vmcnt(0)" ::: "memory");
        } else {
            XB_SPIN(xb_ld(&bar[XB_XGEN(b.x)]) == gen, bar);
            __builtin_amdgcn_fence(__ATOMIC_ACQUIRE, "agent");
            asm volatile("s_waitcnt vmcnt(0)" ::: "memory");
        }
    }
    __syncthreads();
}

constexpr int RING_BYTES = 131072, MISC_OFF = RING_BYTES + 320, LDS_BYTES = 147456;

__device__ __forceinline__ void ph_prologue(Frame& F) {
    float* scr = (float*)(F.lds + F.wave * 16384);
    const int gw = F.vcu * NWAVES + F.wave, NGW = F.G * NWAVES;
    constexpr int I_IN = (D / 64) * (INC / 32), I_CO = (CW / 64) * (D / 32), I_AO = (AW / 64) * (D / 32), I_MX = (D / 64) * (D / 32), I_S1 = (D / 64) * (SD / 32), I_S2 = (SD / 64) * (D / 32);
    constexpr int NIT = I_IN + I_CO + I_AO + I_MX + 2 * I_S1 + I_S2;
    for (int it = gw; it < NIT; it += NGW) {
        int r = it;
        if (r < I_IN) { transpose_item(F.in[1], D, INC, (bf16*)(F.ws + WS_WIN), RMapId{0}, scr, r, F.lane); continue; } r -= I_IN;
        if (r < I_CO) { transpose_item(F.in[4], CW, D, (bf16*)(F.ws + WS_WCO), RMapId{0}, scr, r, F.lane); continue; } r -= I_CO;
        if (r < I_AO) { transpose_item(F.in[5], AW, D, (bf16*)(F.ws + WS_WAO), RMapId{0}, scr, r, F.lane); continue; } r -= I_AO;
        if (r < I_MX) { transpose_item(F.in[6], D, D, (bf16*)(F.ws + WS_WMIX), RMapId{0}, scr, r, F.lane); continue; } r -= I_MX;
        if (r < I_S1) { transpose_item(F.in[14], D, SD, (bf16*)(F.ws + WS_WS13), RMap13{0}, scr, r, F.lane); continue; } r -= I_S1;
        if (r < I_S1) { transpose_item(F.in[15], D, SD, (bf16*)(F.ws + WS_WS13), RMap13{1}, scr, r, F.lane); continue; } r -= I_S1;
        transpose_item(F.in[16], SD, D, (bf16*)(F.ws + WS_WS2), RMapId{0}, scr, r, F.lane);
    }
    const f32x4* x4 = (const f32x4*)F.in[0]; u32x2* xb = (u32x2*)(F.ws + WS_XB);
    const size_t n4 = (size_t)T * D / 4, gt = (size_t)blockIdx.x * NTHR + F.tid, NT_ = (size_t)F.G * NTHR;
    for (size_t i = gt; i < n4; i += NT_) { const f32x4 v = x4[i]; u32x2 o; o.x = pk2(v.x, v.y); o.y = pk2(v.z, v.w); xb[i] = o; }
}

__device__ __forceinline__ void ph_expert_weights(Frame& F) {
    float* scr = (float*)(F.lds + F.wave * 16384);
    const int gw = F.vcu * NWAVES + F.wave, NGW = F.G * NWAVES;
    constexpr int I1 = (D / 64) * (ED / 32), I2 = (ED / 64) * (D / 32), IPE = 2 * I1 + I2;
    for (int it = gw; it < NE * IPE; it += NGW) {
        const int e = it / IPE; int r = it % IPE;
        bf16* w13 = (bf16*)(F.ws + WS_W13T) + (size_t)e * 512 * 1024; bf16* w2 = (bf16*)(F.ws + WS_W2T) + (size_t)e * 1024 * 256;
        if (r < I1) { transpose_item(F.in[11] + (size_t)e * D * ED, D, ED, w13, RMap13{0}, scr, r, F.lane); continue; } r -= I1;
        if (r < I1) { transpose_item(F.in[12] + (size_t)e * D * ED, D, ED, w13, RMap13{1}, scr, r, F.lane); continue; } r -= I1;
        transpose_item(F.in[13] + (size_t)e * ED * D, ED, D, w2, RMapId{0}, scr, r, F.lane);
    }
    constexpr int I_S1 = (D / 64) * (SD / 32), I_S2 = (SD / 64) * (D / 32);
    bf16* w13 = (bf16*)(F.ws + WS_W13T) + (size_t)NE * 512 * 1024; bf16* w2 = (bf16*)(F.ws + WS_W2T) + (size_t)NE * 1024 * 256;
    for (int it = gw; it < 2 * I_S1 + I_S2; it += NGW) {
        int r = it;
        if (r < I_S1) { transpose_item(F.in[14], D, SD, w13, RMap13{0}, scr, r, F.lane); continue; } r -= I_S1;
        if (r < I_S1) { transpose_item(F.in[15], D, SD, w13, RMap13{1}, scr, r, F.lane); continue; } r -= I_S1;
        transpose_item(F.in[16], SD, D, w2, RMapId{0}, scr, r, F.lane);
    }
}

__device__ __forceinline__ void ph_gemm1_simple(Frame& F) {
    const bf16* XB = (const bf16*)(F.ws + WS_XB); const bf16* W = (const bf16*)(F.ws + WS_WIN); bf16* P = (bf16*)(F.ws + WS_PROJ);
    constexpr int NTM = T / 128, NTN = INC / 128;
    for (int it = F.vcu; it < NTM * NTN; it += F.G) {
        const int tm = it / NTN, tn = it % NTN;
        const bf16* A0 = XB + (size_t)tm * 128 * D;
        sg_tile<false>([&](int r) { return A0 + (size_t)r * D; }, W + (size_t)tn * 128 * D, nullptr, D, D, F.wave, F.lane,
            [&](int r, int c, float v, float) { P[(size_t)(tm * 128 + r) * INC + tn * 128 + c] = (bf16)f2bf(v); });
    }
}

__constant__ float ROPE_INV[8] = {1.0f, 0.1939227432012558f, 0.03760603070259094f, 0.007292664609849453f, 0.0014142135623842478f, 0.00027424818836152554f, 5.318296098266728e-05f, 1.0313386155758053e-05f};
__device__ __forceinline__ void ph_post1_simple(Frame& F) {
    const bf16* P = (const bf16*)(F.ws + WS_PROJ);
    bf16* Q = (bf16*)(F.ws + WS_Q); bf16* K = (bf16*)(F.ws + WS_K); bf16* V = (bf16*)(F.ws + WS_V);
    bf16* GC = (bf16*)(F.ws + WS_GC); bf16* GA = (bf16*)(F.ws + WS_GA); bf16* AC = (bf16*)(F.ws + WS_AC);
    const float* bg = F.in[2]; const float* wc = F.in[3];
    const size_t gt = (size_t)blockIdx.x * NTHR + F.tid, NT_ = (size_t)F.G * NTHR;
    for (size_t i = gt; i < (size_t)T * 1024; i += NT_) {
        const int t = (int)(i >> 10), c = (int)(i & 1023), s = t & (SEQ - 1);
        const bf16* pr = P + (size_t)t * INC;
        float y = 0.f;
#pragma unroll
        for (int j = 0; j < 3; ++j) { const int d = 2 - j; if (s - d >= 0) { const bf16* pp = pr - (size_t)d * INC; y += wc[j * CW + c] * (bf2f(pp[C_CC + c]) * bf2f(pp[C_CV + c])); } }
        AC[i] = (bf16)f2bf(bf2f(pr[C_CB + c]) * y);
        GC[i] = (bf16)f2bf(sigmoidf_(bf2f(pr[C_GC + c]) + bg[c]));
        GA[i] = (bf16)f2bf(sigmoidf_(bf2f(pr[C_GA + c]) + bg[D + c]));
    }
    for (size_t i = gt; i < (size_t)T * AW; i += NT_) {
        const int t = (int)(i >> 9), c = (int)(i & 511), d = c & 63, s = t & (SEQ - 1);
        const bf16* pr = P + (size_t)t * INC;
        float q = bf2f(pr[C_Q + c]), k = bf2f(pr[C_K + c]);
        if (d < 16) {
            const int fi = d & 7; const float ang = (float)s * ROPE_INV[fi]; const float cs = cosf(ang), sn = sinf(ang);
            const int pc = (d < 8) ? c + 8 : c - 8; const float q2 = bf2f(pr[C_Q + pc]), k2 = bf2f(pr[C_K + pc]);
            if (d < 8) { q = q * cs - q2 * sn; k = k * cs - k2 * sn; } else { q = q * cs + q2 * sn; k = k * cs + k2 * sn; }
        }
        Q[i] = (bf16)f2bf(q * QSCALE); K[i] = (bf16)f2bf(k); V[i] = pr[C_V + c];
    }
}

__device__ __forceinline__ void ph_kmean_simple(Frame& F) {
    const bf16* K = (const bf16*)(F.ws + WS_K); float* KM = (float*)(F.ws + WS_KMEAN);
    const int gt = blockIdx.x * NTHR + F.tid, NT_ = F.G * NTHR;
    for (int i = gt; i < NB * NH * NBLK * HD; i += NT_) {
        const int d = i & 63, blk = (i >> 6) & 7, h = (i >> 9) & 7, b = i >> 12;
        const bf16* kp = K + (size_t)(b * SEQ + blk * MBLK) * AW + h * HD + d; float s = 0.f;
        for (int r = 0; r < MBLK; ++r) s += bf2f(kp[(size_t)r * AW]);
        KM[i] = s * (1.0f / MBLK);
    }
}

__device__ __forceinline__ void ph_attn_simple(Frame& F) {
    const bf16* Q = (const bf16*)(F.ws + WS_Q); const bf16* K = (const bf16*)(F.ws + WS_K); const bf16* V = (const bf16*)(F.ws + WS_V);
    const float* KM = (const float*)(F.ws + WS_KMEAN); bf16* O = (bf16*)(F.ws + WS_O);
    const int gt = blockIdx.x * NTHR + F.tid, NT_ = F.G * NTHR;
    for (int i = gt; i < NB * NH * SEQ; i += NT_) {
        const int s = i & (SEQ - 1), bh = i >> 11, h = bh & 7, b = bh >> 3, blk = s >> 8;
        const size_t trow = (size_t)(b * SEQ + s);
        bf16x8 q8[8]; float o[64];
        { const bf16x8* qp = (const bf16x8*)(Q + trow * AW + h * HD);
#pragma unroll
          for (int c8 = 0; c8 < 8; ++c8) q8[c8] = qp[c8]; }
#pragma unroll
        for (int d = 0; d < 64; ++d) o[d] = 0.f;
        unsigned sel = 0u;
        if (blk <= 3) sel = (1u << blk) - 1u;
        else {
            float v0 = -INFINITY, v1 = -INFINITY, v2 = -INFINITY; int i0 = 0, i1 = 0, i2 = 0;
#pragma unroll 1
            for (int j = 0; j < blk; ++j) { const float* km = KM + ((size_t)(bh * NBLK + j)) * HD; float a = 0.f;
#pragma unroll
                for (int c8 = 0; c8 < 8; ++c8) { const f32x4 ka = *(const f32x4*)(km + c8 * 8), kb2 = *(const f32x4*)(km + c8 * 8 + 4);
                    a += bf2f((unsigned short)q8[c8][0]) * ka.x + bf2f((unsigned short)q8[c8][1]) * ka.y + bf2f((unsigned short)q8[c8][2]) * ka.z + bf2f((unsigned short)q8[c8][3]) * ka.w;
                    a += bf2f((unsigned short)q8[c8][4]) * kb2.x + bf2f((unsigned short)q8[c8][5]) * kb2.y + bf2f((unsigned short)q8[c8][6]) * kb2.z + bf2f((unsigned short)q8[c8][7]) * kb2.w; }
                if (a > v0) { v2 = v1; i2 = i1; v1 = v0; i1 = i0; v0 = a; i0 = j; }
                else if (a > v1) { v2 = v1; i2 = i1; v1 = a; i1 = j; }
                else if (a > v2) { v2 = a; i2 = j; } }
            sel = (1u << i0) | (1u << i1) | (1u << i2);
        }
        float m = -INFINITY, l = 0.f;
        for (int jj = 0; jj <= blk; ++jj) {
            const int j = (jj == 0) ? blk : jj - 1;
            const bool act = (j == blk) || ((sel >> j) & 1u);
            if (!__any(act)) continue;
            const int kend = (j == blk) ? (s & 255) : 255;
            const bf16* kb = K + (size_t)(b * SEQ + j * MBLK) * AW + h * HD; const bf16* vb = V + (size_t)(b * SEQ + j * MBLK) * AW + h * HD;
#pragma unroll 1
            for (int k0 = 0; k0 < MBLK; ++k0) {
                const bf16x8* kp = (const bf16x8*)(kb + (size_t)k0 * AW); float a = 0.f;
#pragma unroll
                for (int c8 = 0; c8 < 8; ++c8) { const bf16x8 v = kp[c8];
#pragma unroll
                    for (int e = 0; e < 8; ++e) a += bf2f((unsigned short)q8[c8][e]) * bf2f((unsigned short)v[e]); }
                const float sc = (act && k0 <= kend) ? a : -INFINITY;
                if (sc > m) { const float corr = exp2f(m - sc); l *= corr;
#pragma unroll
                    for (int d = 0; d < 64; ++d) o[d] *= corr; m = sc; }
                const float p = exp2f(sc - m); l += p; const bf16x8* vp = (const bf16x8*)(vb + (size_t)k0 * AW);
#pragma unroll
                for (int c8 = 0; c8 < 8; ++c8) { const bf16x8 v = vp[c8];
#pragma unroll
                    for (int e = 0; e < 8; ++e) o[c8 * 8 + e] += p * bf2f((unsigned short)v[e]); }
            }
        }
        const float rl = 1.0f / l; u32x4* op = (u32x4*)(O + trow * AW + h * HD);
#pragma unroll
        for (int c8 = 0; c8 < 8; ++c8) { u32x4 w; w.x = pk2(o[c8 * 8 + 0] * rl, o[c8 * 8 + 1] * rl); w.y = pk2(o[c8 * 8 + 2] * rl, o[c8 * 8 + 3] * rl); w.z = pk2(o[c8 * 8 + 4] * rl, o[c8 * 8 + 5] * rl); w.w = pk2(o[c8 * 8 + 6] * rl, o[c8 * 8 + 7] * rl); op[c8] = w; }
    }
}

__device__ __forceinline__ void ph_branch_out_simple(Frame& F) {
    const bf16* AC = (const bf16*)(F.ws + WS_AC); const bf16* O = (const bf16*)(F.ws + WS_O);
    const bf16* GC = (const bf16*)(F.ws + WS_GC); const bf16* GA = (const bf16*)(F.ws + WS_GA);
    const bf16* Wco = (const bf16*)(F.ws + WS_WCO); const bf16* Wao = (const bf16*)(F.ws + WS_WAO); bf16* MX = (bf16*)(F.ws + WS_MIXED);
    float* tmp = F.out;
    constexpr int NTM = T / 128, NTN = D / 128;
    for (int it = F.vcu; it < NTM * NTN; it += F.G) {
        const int tm = it / NTN, tn = it % NTN;
        const bf16* A0 = AC + (size_t)tm * 128 * CW;
        sg_tile<false>([&](int r) { return A0 + (size_t)r * CW; }, Wco + (size_t)tn * 128 * CW, nullptr, CW, CW, F.wave, F.lane,
            [&](int r, int c, float v, float) { const size_t o = (size_t)(tm * 128 + r) * D + tn * 128 + c; tmp[o] = bf2f(GC[o]) * v; });
        const bf16* A1 = O + (size_t)tm * 128 * AW;
        sg_tile<false>([&](int r) { return A1 + (size_t)r * AW; }, Wao + (size_t)tn * 128 * AW, nullptr, AW, AW, F.wave, F.lane,
            [&](int r, int c, float v, float) { const size_t o = (size_t)(tm * 128 + r) * D + tn * 128 + c; MX[o] = (bf16)f2bf(tmp[o] + bf2f(GA[o]) * v); });
    }
}

__device__ __forceinline__ void ph_mix_simple(Frame& F) {
    const bf16* MX = (const bf16*)(F.ws + WS_MIXED); const bf16* W = (const bf16*)(F.ws + WS_WMIX); const float* x = F.in[0]; float* hp = F.out;
    constexpr int NTM = T / 128, NTN = D / 128;
    for (int it = F.vcu; it < NTM * NTN; it += F.G) {
        const int tm = it / NTN, tn = it % NTN;
        const bf16* A0 = MX + (size_t)tm * 128 * D;
        sg_tile<false>([&](int r) { return A0 + (size_t)r * D; }, W + (size_t)tn * 128 * D, nullptr, D, D, F.wave, F.lane,
            [&](int r, int c, float v, float) { const size_t o = (size_t)(tm * 128 + r) * D + tn * 128 + c; hp[o] = ALPHA * x[o] + v; });
    }
}

__device__ __forceinline__ void ph_ln1_simple(Frame& F) {
    const float* hp = F.out; const float* g = F.in[7]; const float* bta = F.in[8];
    bf16* HI = (bf16*)(F.ws + WS_H1HI); bf16* LO = (bf16*)(F.ws + WS_H1LO);
    const int gw = F.vcu * NWAVES + F.wave, NGW = F.G * NWAVES;
    for (int m = gw; m < T; m += NGW) {
        const f32x4* xr = (const f32x4*)(hp + (size_t)m * D) + F.lane;
        f32x4 v[4]; float s = 0.f;
#pragma unroll
        for (int j = 0; j < 4; ++j) { v[j] = xr[64 * j]; s += (v[j].x + v[j].y) + (v[j].z + v[j].w); }
        const float mean = wave_sum(s) * (1.f / D); float s2 = 0.f;
#pragma unroll
        for (int j = 0; j < 4; ++j) { v[j] = v[j] - mean; s2 += (v[j].x * v[j].x + v[j].y * v[j].y) + (v[j].z * v[j].z + v[j].w * v[j].w); }
        const float rstd = 1.f / sqrtf(wave_sum(s2) * (1.f / D) + LN_EPS);
#pragma unroll
        for (int j = 0; j < 4; ++j) { const int c = 4 * F.lane + 256 * j; const f32x4 gg = *(const f32x4*)(g + c), bb = *(const f32x4*)(bta + c);
            const f32x4 h = v[j] * rstd * gg + bb;
            u32x2 hi, lo; hi.x = pk2(h.x, h.y); hi.y = pk2(h.z, h.w);
            lo.x = pk2(h.x - bf2f(hi.x & 0xffffu), h.y - bf2f(hi.x >> 16)); lo.y = pk2(h.z - bf2f(hi.y & 0xffffu), h.w - bf2f(hi.y >> 16));
            *(u32x2*)(HI + (size_t)m * D + c) = hi; *(u32x2*)(LO + (size_t)m * D + c) = lo; }
    }
}

__device__ __forceinline__ void route_token(Frame& F, int t, f32x4 logit, const float* rbias) {
    const int lane = F.lane;
    int* CNT = (int*)(F.ws + WS_CTL) + CW_CNT; int* BIN = (int*)(F.ws + WS_BIN);
    int* TOPE = (int*)(F.ws + WS_TOPE); int* TOPP = (int*)(F.ws + WS_TOPP); float* TOPW = (float*)(F.ws + WS_TOPW);
    float sc[4], bs[4];
    const f32x4 rb = *(const f32x4*)(rbias + 4 * lane);
#pragma unroll
    for (int j = 0; j < 4; ++j) { sc[j] = sigmoidf_(logit[j]); bs[j] = sc[j] + rb[j]; }
    float m1 = fmaxf(bs[0], bs[1]), m2 = fminf(bs[0], bs[1]);
#pragma unroll
    for (int j = 2; j < 4; ++j) { const float v = bs[j]; m2 = fmaxf(m2, fminf(m1, v)); m1 = fmaxf(m1, v); }
#pragma unroll
    for (int o = 1; o < 8; o <<= 1) { const float o1 = __shfl_xor(m1, o), o2 = __shfl_xor(m2, o); const float n1 = fmaxf(m1, o1), n2 = fmaxf(fminf(m1, o1), fmaxf(m2, o2)); m1 = n1; m2 = n2; }
    const float gs = m1 + m2; const int myg = lane >> 3;
    int rank = 0;
#pragma unroll
    for (int g2 = 0; g2 < 8; ++g2) { const float og = __shfl(gs, g2 * 8); rank += (og > gs || (og == gs && g2 < myg)) ? 1 : 0; }
    const bool gsel = rank < TOPG;
    float mv[4];
#pragma unroll
    for (int j = 0; j < 4; ++j) mv[j] = gsel ? bs[j] : -INFINITY;
    int my_e = -1; float my_w = 0.f; float wsum = 0.f;
#pragma unroll 1
    for (int k = 0; k < TOPK; ++k) {
        float bv = mv[0]; int bi = 4 * lane;
#pragma unroll
        for (int j = 1; j < 4; ++j) if (mv[j] > bv) { bv = mv[j]; bi = 4 * lane + j; }
#pragma unroll
        for (int o = 1; o < 64; o <<= 1) { const float ov = __shfl_xor(bv, o); const int oi = __shfl_xor(bi, o); if (ov > bv || (ov == bv && oi < bi)) { bv = ov; bi = oi; } }
        const int ol = bi >> 2, oj = bi & 3;
        float sv = (oj == 0) ? sc[0] : (oj == 1) ? sc[1] : (oj == 2) ? sc[2] : sc[3];
        sv = __shfl(sv, ol);
        if (lane == ol) { if (oj == 0) mv[0] = -INFINITY; else if (oj == 1) mv[1] = -INFINITY; else if (oj == 2) mv[2] = -INFINITY; else mv[3] = -INFINITY; }
        if (lane == k) { my_e = bi; my_w = sv; }
        wsum += sv;
    }
    if (lane < TOPK) {
        const int pos = atomicAdd(&CNT[my_e], 1);
        BIN[(size_t)my_e * T + pos] = t;
        TOPE[t * TOPK + lane] = my_e; TOPP[t * TOPK + lane] = pos; TOPW[t * TOPK + lane] = my_w / wsum * RSCALE;
    }
}
__device__ __forceinline__ void ph_router_simple(Frame& F) {
    const bf16* HI = (const bf16*)(F.ws + WS_H1HI); const bf16* LO = (const bf16*)(F.ws + WS_H1LO);
    const float* Wr = F.in[9]; const float* rbias = F.in[10];
    const int gw = F.vcu * NWAVES + F.wave, NGW = F.G * NWAVES;
    for (int t0 = gw * 8; t0 < T; t0 += NGW * 8) {
        f32x4 acc[8];
#pragma unroll
        for (int i = 0; i < 8; ++i) acc[i] = (f32x4){0.f, 0.f, 0.f, 0.f};
        for (int k0 = 0; k0 < D; k0 += 64) {
            float hv[8];
#pragma unroll
            for (int i = 0; i < 8; ++i) { const size_t o = (size_t)(t0 + i) * D + k0 + F.lane; hv[i] = bf2f(HI[o]) + bf2f(LO[o]); }
#pragma unroll 8
            for (int kk = 0; kk < 64; ++kk) {
                const f32x4 w = *(const f32x4*)(Wr + (size_t)(k0 + kk) * NE + 4 * F.lane);
#pragma unroll
                for (int i = 0; i < 8; ++i) { const float hb = __builtin_bit_cast(float, __builtin_amdgcn_readlane(__builtin_bit_cast(int, hv[i]), kk)); acc[i] += w * hb; }
            }
        }
#pragma unroll
        for (int i = 0; i < 8; ++i) route_token(F, t0 + i, acc[i], rbias);
    }
}

template <int TR> __device__ __forceinline__ void build_tables(Frame& F, int* cnt, int* base, int* tb) {
    const int* CNT = (const int*)(F.ws + WS_CTL) + CW_CNT;
    __syncthreads();
    for (int e = F.tid; e < NE + 1; e += NTHR) cnt[e] = (e < NE) ? __hip_atomic_load(CNT + e, __ATOMIC_RELAXED, __HIP_MEMORY_SCOPE_AGENT) : T;
    __syncthreads();
    if (F.tid == 0) { int b = 0, t = 0; for (int e = 0; e <= NE; ++e) { base[e] = b; tb[e] = t; b += cnt[e]; t += (cnt[e] + TR - 1) / TR; } base[NE + 1] = b; tb[NE + 1] = t; }
    __syncthreads();
}
__device__ __forceinline__ int find_expert(const int* tb, int tile) {
    int lo = 0, hi = NE;
    while (lo < hi) { const int mid = (lo + hi + 1) >> 1; if (tb[mid] <= tile) lo = mid; else hi = mid - 1; }
    return lo;
}

__device__ __forceinline__ void ph_up_simple(Frame& F) {
    int* cnt = (int*)(F.lds); int* base = cnt + 320; int* tb = base + 320;
    build_tables<128>(F, cnt, base, tb);
    const bf16* HI = (const bf16*)(F.ws + WS_H1HI); const int* BIN = (const int*)(F.ws + WS_BIN);
    const bf16* W13 = (const bf16*)(F.ws + WS_W13T); bf16* HID = (bf16*)(F.ws + WS_HID);
    const int ntile = tb[NE + 1];
    for (int it = F.vcu; it < ntile * 2; it += F.G) {
        const int tile = it >> 1, pn = it & 1, e = find_expert(tb, tile), rt = tile - tb[e], ce = cnt[e], r0 = rt * 128;
        const int* bin = BIN + (size_t)e * T;
        const bf16* B1 = W13 + (size_t)e * 512 * 1024 + (size_t)(256 * pn) * 1024;
        sg_tile<true>([&](int r) { int rr = r0 + r; if (rr >= ce) rr = ce - 1; const int tok = (e < NE) ? bin[rr] : rr; return HI + (size_t)tok * D; },
            B1, B1 + (size_t)128 * 1024, 1024, D, F.wave, F.lane,
            [&](int r, int c, float v1, float v3) { if (r0 + r < ce) { const float hsw = v1 * sigmoidf_(v1) * v3; HID[(size_t)(base[e] + r0 + r) * ED + 128 * pn + c] = (bf16)f2bf(hsw); } });
    }
}
__device__ __forceinline__ void ph_down_simple(Frame& F) {
    int* cnt = (int*)(F.lds); int* base = cnt + 320; int* tb = base + 320;
    build_tables<128>(F, cnt, base, tb);
    const bf16* HID = (const bf16*)(F.ws + WS_HID); const bf16* W2 = (const bf16*)(F.ws + WS_W2T); bf16* Y = (bf16*)(F.ws + WS_Y);
    const int ntile = tb[NE + 1];
    for (int it = F.vcu; it < ntile * 8; it += F.G) {
        const int tile = it >> 3, pn = it & 7, e = find_expert(tb, tile), rt = tile - tb[e], ce = cnt[e], r0 = rt * 128;
        const bf16* A0 = HID + (size_t)base[e] * ED;
        sg_tile<false>([&](int r) { int rr = r0 + r; if (rr >= ce) rr = ce - 1; return A0 + (size_t)rr * ED; },
            W2 + (size_t)e * 1024 * 256 + (size_t)(128 * pn) * 256, nullptr, 256, ED, F.wave, F.lane,
            [&](int r, int c, float v, float) { if (r0 + r < ce) Y[(size_t)(base[e] + r0 + r) * D + 128 * pn + c] = (bf16)f2bf(v); });
    }
}
__device__ __forceinline__ void ph_final_simple(Frame& F) {
    int* cnt = (int*)(F.lds); int* base = cnt + 320; int* tb = base + 320;
    build_tables<128>(F, cnt, base, tb);
    const bf16* HI = (const bf16*)(F.ws + WS_H1HI); const bf16* LO = (const bf16*)(F.ws + WS_H1LO); const bf16* Y = (const bf16*)(F.ws + WS_Y);
    const int* TOPE = (const int*)(F.ws + WS_TOPE); const int* TOPP = (const int*)(F.ws + WS_TOPP); const float* TOPW = (const float*)(F.ws + WS_TOPW);
    const float* g = F.in[17]; const float* bta = F.in[18];
    const int gw = F.vcu * NWAVES + F.wave, NGW = F.G * NWAVES;
    for (int t = gw; t < T; t += NGW) {
        f32x4 v[4];
#pragma unroll
        for (int j = 0; j < 4; ++j) { const int c = 4 * F.lane + 256 * j; const u32x2 hi = *(const u32x2*)(HI + (size_t)t * D + c), lo = *(const u32x2*)(LO + (size_t)t * D + c);
            v[j].x = ALPHA * (bf2f(hi.x & 0xffffu) + bf2f(lo.x & 0xffffu)); v[j].y = ALPHA * (bf2f(hi.x >> 16) + bf2f(lo.x >> 16));
            v[j].z = ALPHA * (bf2f(hi.y & 0xffffu) + bf2f(lo.y & 0xffffu)); v[j].w = ALPHA * (bf2f(hi.y >> 16) + bf2f(lo.y >> 16)); }
        for (int k = 0; k <= TOPK; ++k) {
            int slot; float w;
            if (k < TOPK) { const int e = TOPE[t * TOPK + k]; slot = base[e] + TOPP[t * TOPK + k]; w = TOPW[t * TOPK + k]; } else { slot = NA + t; w = 1.0f; }
#pragma unroll
            for (int j = 0; j < 4; ++j) { const int c = 4 * F.lane + 256 * j; const u32x2 y = *(const u32x2*)(Y + (size_t)slot * D + c);
                v[j].x += w * bf2f(y.x & 0xffffu); v[j].y += w * bf2f(y.x >> 16); v[j].z += w * bf2f(y.y & 0xffffu); v[j].w += w * bf2f(y.y >> 16); }
        }
        float s = 0.f;
#pragma unroll
        for (int j = 0; j < 4; ++j) s += (v[j].x + v[j].y) + (v[j].z + v[j].w);
        const float mean = wave_sum(s) * (1.f / D); float s2 = 0.f;
#pragma unroll
        for (int j = 0; j < 4; ++j) { v[j] = v[j] - mean; s2 += (v[j].x * v[j].x + v[j].y * v[j].y) + (v[j].z * v[j].z + v[j].w * v[j].w); }
        const float rstd = 1.f / sqrtf(wave_sum(s2) * (1.f / D) + LN_EPS);
#pragma unroll
        for (int j = 0; j < 4; ++j) { const int c = 4 * F.lane + 256 * j; const f32x4 gg = *(const f32x4*)(g + c), bb = *(const f32x4*)(bta + c);
            *(f32x4*)(F.out + (size_t)t * D + c) = v[j] * rstd * gg + bb; }
    }
}

constexpr int N_PHASES = 13;
struct Args { const float* in[19]; float* out; unsigned char* ws; int ph_lo, ph_hi; };
__global__ void __launch_bounds__(NTHR, 2) fwd_kernel(Args args) {
    extern __shared__ __attribute__((aligned(16))) unsigned char lds[];
    Frame F;
    F.lds = lds; F.tid = threadIdx.x; F.lane = F.tid & 63; F.wave = __builtin_amdgcn_readfirstlane(F.tid >> 6);
    F.G = gridDim.x; { const int bx = blockIdx.x; F.vcu = (F.G % 8 == 0) ? (bx % 8) * (F.G / 8) + bx / 8 : bx; }
#pragma unroll
    for (int i = 0; i < 19; ++i) F.in[i] = args.in[i];
    F.out = args.out; F.ws = args.ws;
    volatile LAS unsigned* MISC = (volatile LAS unsigned*)((LAS unsigned char*)lds + MISC_OFF);
    if (F.tid < 32) MISC[F.tid] = 0u;
    __syncthreads();
#if MK_SINGLE
    XcdBarrier bar = xcd_barrier_post((unsigned*)(F.ws + WS_CTL) + CW_BAR, MISC + 8);
#define SEAM() xcd_barrier(bar)
#else
#define SEAM() do {} while (0)
#endif
    const int lo = args.ph_lo, hi = args.ph_hi;
#define IN(k) (lo <= (k) && (k) < hi)
#define BOTH(k) (IN(k) && IN((k) + 1))
    if (IN(0))  { ph_prologue(F);          if (BOTH(0))  SEAM(); }
    if (IN(1))  { ph_gemm1_simple(F);      if (BOTH(1))  SEAM(); }
    if (IN(2))  { ph_post1_simple(F);      if (BOTH(2))  SEAM(); }
    if (IN(3))  { ph_kmean_simple(F);      if (BOTH(3))  SEAM(); }
    if (IN(4))  { ph_attn_simple(F);       if (BOTH(4))  SEAM(); }
    if (IN(5))  { ph_branch_out_simple(F); if (BOTH(5))  SEAM(); }
    if (IN(6))  { ph_mix_simple(F);        if (BOTH(6))  SEAM(); }
    if (IN(7))  { ph_ln1_simple(F);        if (BOTH(7))  SEAM(); }
    if (IN(8))  { ph_router_simple(F);     if (BOTH(8))  SEAM(); }
    if (IN(9))  { ph_expert_weights(F);    if (BOTH(9))  SEAM(); }
    if (IN(10)) { ph_up_simple(F);         if (BOTH(10)) SEAM(); }
    if (IN(11)) { ph_down_simple(F);       if (BOTH(11)) SEAM(); }
    if (IN(12)) { ph_final_simple(F);      if (BOTH(12)) SEAM(); }
#undef IN
#undef BOTH
}

extern "C" void kernel_launch(void* const* d_in, const int* in_sizes, int n_in, void* d_out, int out_size, void* d_ws, size_t ws_size, hipStream_t stream) {
    static int grid = 0;
    if (grid == 0) {
        if (n_in != 19 || in_sizes[0] != T * D || out_size != T * D || ws_size < WS_END) { fprintf(stderr, "kernel_launch: unexpected shapes / workspace (n_in %d, ws %zu, need %zu); nothing launched\n", n_in, ws_size, (size_t)WS_END); grid = -1; return; }
        int dev = 0, cus = 0, per_cu = 0;
        if (hipGetDevice(&dev) != hipSuccess || hipDeviceGetAttribute(&cus, hipDeviceAttributeMultiprocessorCount, dev) != hipSuccess) { grid = -1; return; }
        if (hipFuncSetAttribute((const void*)fwd_kernel, hipFuncAttributeMaxDynamicSharedMemorySize, LDS_BYTES) != hipSuccess) { fprintf(stderr, "kernel_launch: hipFuncSetAttribute failed\n"); grid = -1; return; }
        if (hipOccupancyMaxActiveBlocksPerMultiprocessor(&per_cu, (const void*)fwd_kernel, NTHR, LDS_BYTES) != hipSuccess || per_cu < 1) { fprintf(stderr, "kernel_launch: occupancy query says %d blocks/CU\n", per_cu); per_cu = 1; }
        (void)hipGetLastError();
        grid = cus;
    }
    if (grid < 0) return;
    (void)hipMemsetAsync((char*)d_ws + WS_CTL, 0, CTL_BYTES, stream);
    Args a{};
    for (int i = 0; i < 19; ++i) a.in[i] = (const float*)d_in[i];
    a.out = (float*)d_out; a.ws = (unsigned char*)d_ws;
#if MK_SINGLE
    a.ph_lo = 0; a.ph_hi = N_PHASES;
    hipLaunchKernelGGL(fwd_kernel, dim3(grid), dim3(NTHR), LDS_BYTES, stream, a);
#else
    for (int p = 0; p < N_PHASES; ++p) { a.ph_lo = p; a.ph_hi = p + 1; hipLaunchKernelGGL(fwd_kernel, dim3(grid), dim3(NTHR), LDS_BYTES, stream, a); }
#endif
}
```

```cpp
#include <hip/hip_runtime.h>
#include <cstdio>
#include <cstdint>

#ifndef MK_SINGLE
#define MK_SINGLE 1
#endif

constexpr int NB = 16, SEQ = 2048, T = NB * SEQ, D = 1024;
constexpr int CW = 1024, NH = 8, HD = 64, AW = 512, MBLK = 256, NBLK = SEQ / MBLK;
constexpr int INC = 3 * CW + 3 * AW + 2 * D;
constexpr int C_CB = 0, C_CC = 1024, C_CV = 2048, C_Q = 3072, C_K = 3584, C_V = 4096, C_GC = 4608, C_GA = 5632;
constexpr int NE = 256, TOPK = 8, NG = 8, TOPG = 4, ED = 256, SD = 256;
constexpr int NA = T * TOPK;
constexpr int NSLOT = NA + T;
constexpr float ALPHA = 1.189207115002721f, LN_EPS = 1e-5f, RSCALE = 2.5f;
constexpr float QSCALE = 0.125f * 1.4426950408889634f;
constexpr int NWAVES = 8, NTHR = 512;

constexpr size_t MiB = 1u << 20;
constexpr size_t WS_CTL = 0, CTL_BYTES = 1 * MiB;
constexpr size_t WS_KMEAN = 1 * MiB;
constexpr size_t WS_WIN = 2 * MiB;
constexpr size_t WS_WCO = 15 * MiB, WS_WAO = 17 * MiB, WS_WMIX = 18 * MiB, WS_WS13 = 20 * MiB, WS_WS2 = 21 * MiB;
constexpr size_t WS_TOPE = 24 * MiB, WS_TOPP = 25 * MiB, WS_TOPW = 26 * MiB;
constexpr size_t WS_H1HI = 28 * MiB, WS_H1LO = 92 * MiB;
constexpr size_t WS_W2T = 156 * MiB;
constexpr size_t WS_HID = 285 * MiB;
constexpr size_t WS_W13T = 429 * MiB;
constexpr size_t WS_BIN = 686 * MiB;
constexpr size_t WS_Y = 429 * MiB;
constexpr size_t WS_XB = 156 * MiB;
constexpr size_t WS_PROJ = 220 * MiB;
constexpr size_t WS_Q = 636 * MiB, WS_K = 668 * MiB, WS_V = 700 * MiB;
constexpr size_t WS_GC = 732 * MiB, WS_GA = 796 * MiB, WS_AC = 860 * MiB;
constexpr size_t WS_O = 924 * MiB;
constexpr size_t WS_MIXED = 956 * MiB;
constexpr size_t WS_END = 1020 * MiB;
constexpr int CW_TMO = 0, CW_CNT = 1024  , CW_BAR = 4096;

typedef unsigned short bf16;
typedef short bf16x8 __attribute__((ext_vector_type(8)));
typedef float f32x4 __attribute__((ext_vector_type(4)));
typedef unsigned u32x4 __attribute__((ext_vector_type(4)));
typedef unsigned u32x2 __attribute__((ext_vector_type(2)));
#define LAS __attribute__((address_space(3)))

__device__ __forceinline__ unsigned f2bf(float f) { unsigned u = __builtin_bit_cast(unsigned, f); return (u + 0x7fffu + ((u >> 16) & 1u)) >> 16; }
__device__ __forceinline__ float bf2f(unsigned h) { return __builtin_bit_cast(float, h << 16); }
__device__ __forceinline__ unsigned pk2(float lo, float hi) { return f2bf(lo) | (f2bf(hi) << 16); }
__device__ __forceinline__ float sigmoidf_(float x) { return 1.0f / (1.0f + __expf(-x)); }
__device__ __forceinline__ float wave_sum(float v) {
#pragma unroll
    for (int o = 1; o < 64; o <<= 1) v += __shfl_xor(v, o);
    return v;
}

struct Frame {
    unsigned char* lds;
    int tid, lane, wave, vcu, G;
    const float* in[19]; float* out; unsigned char* ws;
};

template <class RMap>
__device__ __forceinline__ void transpose_item(const float* W, int K, int N, bf16* WT, RMap rmap, float* scr, int item, int lane) {
    const int nblk = N / 32, kb = item / nblk, nb = item % nblk, k0 = 64 * kb, n0 = 32 * nb;
#pragma unroll 8
    for (int i = 0; i < 32; ++i) { const int kk = 2 * i + (lane >> 5); scr[kk * 33 + (lane & 31)] = W[(size_t)(k0 + kk) * N + n0 + (lane & 31)]; }
    asm volatile("s_waitcnt vmcnt(0) lgkmcnt(0)" ::: "memory");
    const int c = lane & 7;
#pragma unroll
    for (int j = 0; j < 4; ++j) { const int n = (lane >> 3) + 8 * j; const float* s = scr + (8 * c) * 33 + n;
        u32x4 o; o.x = pk2(s[0 * 33], s[1 * 33]); o.y = pk2(s[2 * 33], s[3 * 33]); o.z = pk2(s[4 * 33], s[5 * 33]); o.w = pk2(s[6 * 33], s[7 * 33]);
        *(u32x4*)(WT + (size_t)rmap(n0 + n) * K + k0 + 8 * c) = o; }
    asm volatile("s_waitcnt vmcnt(0) lgkmcnt(0)" ::: "memory");
}
struct RMapId { int off; __device__ __forceinline__ int operator()(int n) const { return off + n; } };
struct RMap13 { int which; __device__ __forceinline__ int operator()(int n) const { return 256 * (n >> 7) + 128 * which + (n & 127); } };

template <bool DUAL, class ARow, class Epi>
__device__ __forceinline__ void sg_tile(ARow arow, const bf16* Bt, const bf16* Bt2, size_t ldb, int K, int wave, int lane, Epi epi) {
    const int wr = wave >> 1, wc = wave & 1, fr = lane & 15, fq = lane >> 4;
    f32x4 acc[2][4], acc2[2][4];
#pragma unroll
    for (int i = 0; i < 2; ++i)
#pragma unroll
        for (int j = 0; j < 4; ++j) { acc[i][j] = (f32x4){0.f, 0.f, 0.f, 0.f}; acc2[i][j] = (f32x4){0.f, 0.f, 0.f, 0.f}; }
    const bf16* ap[2]; const bf16* bp[4]; const bf16* bp2[4];
#pragma unroll
    for (int i = 0; i < 2; ++i) ap[i] = arow(32 * wr + 16 * i + fr) + 8 * fq;
#pragma unroll
    for (int j = 0; j < 4; ++j) { bp[j] = Bt + (size_t)(64 * wc + 16 * j + fr) * ldb + 8 * fq; bp2[j] = DUAL ? Bt2 + (size_t)(64 * wc + 16 * j + fr) * ldb + 8 * fq : bp[j]; }
    for (int k0 = 0; k0 < K; k0 += 32) {
        bf16x8 a[2], b[4], b2[4];
#pragma unroll
        for (int i = 0; i < 2; ++i) a[i] = *(const bf16x8*)(ap[i] + k0);
#pragma unroll
        for (int j = 0; j < 4; ++j) { b[j] = *(const bf16x8*)(bp[j] + k0); if (DUAL) b2[j] = *(const bf16x8*)(bp2[j] + k0); }
#pragma unroll
        for (int i = 0; i < 2; ++i)
#pragma unroll
            for (int j = 0; j < 4; ++j) { acc[i][j] = __builtin_amdgcn_mfma_f32_16x16x32_bf16(a[i], b[j], acc[i][j], 0, 0, 0);
                if (DUAL) acc2[i][j] = __builtin_amdgcn_mfma_f32_16x16x32_bf16(a[i], b2[j], acc2[i][j], 0, 0, 0); }
    }
#pragma unroll
    for (int i = 0; i < 2; ++i)
#pragma unroll
        for (int j = 0; j < 4; ++j)
#pragma unroll
            for (int r = 0; r < 4; ++r) epi(32 * wr + 16 * i + 4 * fq + r, 64 * wc + 16 * j + fr, acc[i][j][r], acc2[i][j][r]);
}

#define XB_TMO      128
#define XB_XCNT(j)  (256  + 64 * (j))
#define XB_XSUB(j)  (1280 + 64 * (j))
#define XB_XGEN(j)  (2304 + 64 * (j))
#define XB_TOP      3328
#define XB_TOPGEN   3392
#define XCD_BAR_WORDS 3456
#define XB_SPIN_CAP (1u << 22)
__device__ __forceinline__ unsigned xb_ld(unsigned* p)              { return __hip_atomic_load(p, __ATOMIC_RELAXED, __HIP_MEMORY_SCOPE_AGENT); }
__device__ __forceinline__ unsigned xb_add(unsigned* p, unsigned v) { return __hip_atomic_fetch_add(p, v, __ATOMIC_RELAXED, __HIP_MEMORY_SCOPE_AGENT); }
__device__ __forceinline__ unsigned xb_xcc_id() { return (unsigned)__builtin_amdgcn_s_getreg((3 << 11) | 20) & 0xFu; }
#define XB_SPIN(cond, bar) do { unsigned _sp = 0; while (cond) { __builtin_amdgcn_s_sleep(1); \
    if ((++_sp & 255u) == 0u) { if (xb_ld(&(bar)[XB_TMO])) break; if (_sp > XB_SPIN_CAP) { atomicAdd(&(bar)[XB_TMO], 1u); break; } } } } while (0)
struct XcdBarrier { unsigned* bar; unsigned x; volatile LAS unsigned* st; };
__device__ __forceinline__ XcdBarrier xcd_barrier_post(unsigned* bar, volatile LAS unsigned* st) {
    XcdBarrier b; b.bar = bar; b.x = xb_xcc_id(); b.st = st;
    if (threadIdx.x == 0) (void)xb_add(&bar[XB_XCNT(b.x)], 1u);
    return b;
}
__device__ __forceinline__ void xcd_barrier_complete(unsigned* bar, unsigned x, unsigned& nloc, unsigned& nx) {
    const unsigned G = gridDim.x * gridDim.y * gridDim.z;
    unsigned sum, cnt, mine, sp = 0u;
    for (;;) {
        sum = 0u; cnt = 0u; mine = 0u;
#pragma unroll
        for (unsigned j = 0; j < 16; ++j) { const unsigned c = xb_ld(&bar[XB_XCNT(j)]); sum += c; cnt += (c > 0u) ? 1u : 0u; mine = (j == x) ? c : mine; }
        if (sum == G) break;
        __builtin_amdgcn_s_sleep(1);
        if ((++sp & 255u) == 0u) { if (xb_ld(&bar[XB_TMO])) break; if (sp > XB_SPIN_CAP) { atomicAdd(&bar[XB_TMO], 1u); break; } }
    }
    nloc = mine > 0u ? mine : 1u; nx = cnt > 0u ? cnt : 1u;
}
__device__ __forceinline__ void xcd_barrier(const XcdBarrier& b) {
    asm volatile("s_waitcnt vmcnt(0)" ::: "memory");
    __syncthreads();
    if (threadIdx.x == 0) {
        unsigned* bar = b.bar;
        __builtin_amdgcn_s_waitcnt(0);
        unsigned nloc = b.st[0], nx = b.st[1];
        if (nloc == 0u) { xcd_barrier_complete(bar, b.x, nloc, nx); b.st[0] = nloc; b.st[1] = nx; }
        const unsigned old = xb_add(&bar[XB_XSUB(b.x)], 1u);
        const unsigned gen = old / nloc;
        if (old + 1u == (gen + 1u) * nloc) {
            __builtin_amdgcn_fence(__ATOMIC_RELEASE, "agent");
            asm volatile("s_waitcnt vmcnt(0)" ::: "memory");
            const unsigned og = xb_add(&bar[XB_TOP], 1u);
            const unsigned tg = og / nx;
            if (og + 1u == (tg + 1u) * nx) xb_add(&bar[XB_TOPGEN], 1u);
            else XB_SPIN(xb_ld(&bar[XB_TOPGEN]) == tg, bar);
            __builtin_amdgcn_fence(__ATOMIC_ACQUIRE, "agent");
            xb_add(&bar[XB_XGEN(b.x)], 1u);
            asm volatile("s_waitcnt vmcnt(0)" ::: "memory");
        } else {
            XB_SPIN(xb_ld(&bar[XB_XGEN(b.x)]) == gen, bar);
            __builtin_amdgcn_fence(__ATOMIC_ACQUIRE, "agent");
            asm volatile("s_waitcnt vmcnt(0)" ::: "memory");
        }
    }
    __syncthreads();
}

constexpr int RING_BYTES = 131072, MISC_OFF = RING_BYTES + 320, LDS_BYTES = 147456;

__device__ __forceinline__ void ph_prologue(Frame& F) {
    float* scr = (float*)(F.lds + F.wave * 16384);
    const int gw = F.vcu * NWAVES + F.wave, NGW = F.G * NWAVES;
    constexpr int I_IN = (D / 64) * (INC / 32), I_CO = (CW / 64) * (D / 32), I_AO = (AW / 64) * (D / 32), I_MX = (D / 64) * (D / 32), I_S1 = (D / 64) * (SD / 32), I_S2 = (SD / 64) * (D / 32);
    constexpr int NIT = I_IN + I_CO + I_AO + I_MX + 2 * I_S1 + I_S2;
    for (int it = gw; it < NIT; it += NGW) {
        int r = it;
        if (r < I_IN) { transpose_item(F.in[1], D, INC, (bf16*)(F.ws + WS_WIN), RMapId{0}, scr, r, F.lane); continue; } r -= I_IN;
        if (r < I_CO) { transpose_item(F.in[4], CW, D, (bf16*)(F.ws + WS_WCO), RMapId{0}, scr, r, F.lane); continue; } r -= I_CO;
        if (r < I_AO) { transpose_item(F.in[5], AW, D, (bf16*)(F.ws + WS_WAO), RMapId{0}, scr, r, F.lane); continue; } r -= I_AO;
        if (r < I_MX) { transpose_item(F.in[6], D, D, (bf16*)(F.ws + WS_WMIX), RMapId{0}, scr, r, F.lane); continue; } r -= I_MX;
        if (r < I_S1) { transpose_item(F.in[14], D, SD, (bf16*)(F.ws + WS_WS13), RMap13{0}, scr, r, F.lane); continue; } r -= I_S1;
        if (r < I_S1) { transpose_item(F.in[15], D, SD, (bf16*)(F.ws + WS_WS13), RMap13{1}, scr, r, F.lane); continue; } r -= I_S1;
        transpose_item(F.in[16], SD, D, (bf16*)(F.ws + WS_WS2), RMapId{0}, scr, r, F.lane);
    }
    const f32x4* x4 = (const f32x4*)F.in[0]; u32x2* xb = (u32x2*)(F.ws + WS_XB);
    const size_t n4 = (size_t)T * D / 4, gt = (size_t)blockIdx.x * NTHR + F.tid, NT_ = (size_t)F.G * NTHR;
    for (size_t i = gt; i < n4; i += NT_) { const f32x4 v = x4[i]; u32x2 o; o.x = pk2(v.x, v.y); o.y = pk2(v.z, v.w); xb[i] = o; }
}

__device__ __forceinline__ void ph_expert_weights(Frame& F) {
    float* scr = (float*)(F.lds + F.wave * 16384);
    const int gw = F.vcu * NWAVES + F.wave, NGW = F.G * NWAVES;
    constexpr int I1 = (D / 64) * (ED / 32), I2 = (ED / 64) * (D / 32), IPE = 2 * I1 + I2;
    for (int it = gw; it < NE * IPE; it += NGW) {
        const int e = it / IPE; int r = it % IPE;
        bf16* w13 = (bf16*)(F.ws + WS_W13T) + (size_t)e * 512 * 1024; bf16* w2 = (bf16*)(F.ws + WS_W2T) + (size_t)e * 1024 * 256;
        if (r < I1) { transpose_item(F.in[11] + (size_t)e * D * ED, D, ED, w13, RMap13{0}, scr, r, F.lane); continue; } r -= I1;
        if (r < I1) { transpose_item(F.in[12] + (size_t)e * D * ED, D, ED, w13, RMap13{1}, scr, r, F.lane); continue; } r -= I1;
        transpose_item(F.in[13] + (size_t)e * ED * D, ED, D, w2, RMapId{0}, scr, r, F.lane);
    }
    constexpr int I_S1 = (D / 64) * (SD / 32), I_S2 = (SD / 64) * (D / 32);
    bf16* w13 = (bf16*)(F.ws + WS_W13T) + (size_t)NE * 512 * 1024; bf16* w2 = (bf16*)(F.ws + WS_W2T) + (size_t)NE * 1024 * 256;
    for (int it = gw; it < 2 * I_S1 + I_S2; it += NGW) {
        int r = it;
        if (r < I_S1) { transpose_item(F.in[14], D, SD, w13, RMap13{0}, scr, r, F.lane); continue; } r -= I_S1;
        if (r < I_S1) { transpose_item(F.in[15], D, SD, w13, RMap13{1}, scr, r, F.lane); continue; } r -= I_S1;
        transpose_item(F.in[16], SD, D, w2, RMapId{0}, scr, r, F.lane);
    }
}

__device__ __forceinline__ void ph_gemm1_simple(Frame& F) {
    const bf16* XB = (const bf16*)(F.ws + WS_XB); const bf16* W = (const bf16*)(F.ws + WS_WIN); bf16* P = (bf16*)(F.ws + WS_PROJ);
    constexpr int NTM = T / 128, NTN = INC / 128;
    for (int it = F.vcu; it < NTM * NTN; it += F.G) {
        const int tm = it / NTN, tn = it % NTN;
        const bf16* A0 = XB + (size_t)tm * 128 * D;
        sg_tile<false>([&](int r) { return A0 + (size_t)r * D; }, W + (size_t)tn * 128 * D, nullptr, D, D, F.wave, F.lane,
            [&](int r, int c, float v, float) { P[(size_t)(tm * 128 + r) * INC + tn * 128 + c] = (bf16)f2bf(v); });
    }
}

__constant__ float ROPE_INV[8] = {1.0f, 0.1939227432012558f, 0.03760603070259094f, 0.007292664609849453f, 0.0014142135623842478f, 0.00027424818836152554f, 5.318296098266728e-05f, 1.0313386155758053e-05f};
__device__ __forceinline__ void ph_post1_simple(Frame& F) {
    const bf16* P = (const bf16*)(F.ws + WS_PROJ);
    bf16* Q = (bf16*)(F.ws + WS_Q); bf16* K = (bf16*)(F.ws + WS_K); bf16* V = (bf16*)(F.ws + WS_V);
    bf16* GC = (bf16*)(F.ws + WS_GC); bf16* GA = (bf16*)(F.ws + WS_GA); bf16* AC = (bf16*)(F.ws + WS_AC);
    const float* bg = F.in[2]; const float* wc = F.in[3];
    const size_t gt = (size_t)blockIdx.x * NTHR + F.tid, NT_ = (size_t)F.G * NTHR;
    for (size_t i = gt; i < (size_t)T * 1024; i += NT_) {
        const int t = (int)(i >> 10), c = (int)(i & 1023), s = t & (SEQ - 1);
        const bf16* pr = P + (size_t)t * INC;
        float y = 0.f;
#pragma unroll
        for (int j = 0; j < 3; ++j) { const int d = 2 - j; if (s - d >= 0) { const bf16* pp = pr - (size_t)d * INC; y += wc[j * CW + c] * (bf2f(pp[C_CC + c]) * bf2f(pp[C_CV + c])); } }
        AC[i] = (bf16)f2bf(bf2f(pr[C_CB + c]) * y);
        GC[i] = (bf16)f2bf(sigmoidf_(bf2f(pr[C_GC + c]) + bg[c]));
        GA[i] = (bf16)f2bf(sigmoidf_(bf2f(pr[C_GA + c]) + bg[D + c]));
    }
    for (size_t i = gt; i < (size_t)T * AW; i += NT_) {
        const int t = (int)(i >> 9), c = (int)(i & 511), d = c & 63, s = t & (SEQ - 1);
        const bf16* pr = P + (size_t)t * INC;
        float q = bf2f(pr[C_Q + c]), k = bf2f(pr[C_K + c]);
        if (d < 16) {
            const int fi = d & 7; const float ang = (float)s * ROPE_INV[fi]; const float cs = cosf(ang), sn = sinf(ang);
            const int pc = (d < 8) ? c + 8 : c - 8; const float q2 = bf2f(pr[C_Q + pc]), k2 = bf2f(pr[C_K + pc]);
            if (d < 8) { q = q * cs - q2 * sn; k = k * cs - k2 * sn; } else { q = q * cs + q2 * sn; k = k * cs + k2 * sn; }
        }
        Q[i] = (bf16)f2bf(q * QSCALE); K[i] = (bf16)f2bf(k); V[i] = pr[C_V + c];
    }
}

__device__ __forceinline__ void ph_kmean_simple(Frame& F) {
    const bf16* K = (const bf16*)(F.ws + WS_K); float* KM = (float*)(F.ws + WS_KMEAN);
    const int gt = blockIdx.x * NTHR + F.tid, NT_ = F.G * NTHR;
    for (int i = gt; i < NB * NH * NBLK * HD; i += NT_) {
        const int d = i & 63, blk = (i >> 6) & 7, h = (i >> 9) & 7, b = i >> 12;
        const bf16* kp = K + (size_t)(b * SEQ + blk * MBLK) * AW + h * HD + d; float s = 0.f;
        for (int r = 0; r < MBLK; ++r) s += bf2f(kp[(size_t)r * AW]);
        KM[i] = s * (1.0f / MBLK);
    }
}

__device__ __forceinline__ void ph_attn_simple(Frame& F) {
    const bf16* Q = (const bf16*)(F.ws + WS_Q); const bf16* K = (const bf16*)(F.ws + WS_K); const bf16* V = (const bf16*)(F.ws + WS_V);
    const float* KM = (const float*)(F.ws + WS_KMEAN); bf16* O = (bf16*)(F.ws + WS_O);
    const int gt = blockIdx.x * NTHR + F.tid, NT_ = F.G * NTHR;
    for (int i = gt; i < NB * NH * SEQ; i += NT_) {
        const int s = i & (SEQ - 1), bh = i >> 11, h = bh & 7, b = bh >> 3, blk = s >> 8;
        const size_t trow = (size_t)(b * SEQ + s);
        bf16x8 q8[8]; float o[64];
        { const bf16x8* qp = (const bf16x8*)(Q + trow * AW + h * HD);
#pragma unroll
          for (int c8 = 0; c8 < 8; ++c8) q8[c8] = qp[c8]; }
#pragma unroll
        for (int d = 0; d < 64; ++d) o[d] = 0.f;
        unsigned sel = 0u;
        if (blk <= 3) sel = (1u << blk) - 1u;
        else {
            float v0 = -INFINITY, v1 = -INFINITY, v2 = -INFINITY; int i0 = 0, i1 = 0, i2 = 0;
#pragma unroll 1
            for (int j = 0; j < blk; ++j) { const float* km = KM + ((size_t)(bh * NBLK + j)) * HD; float a = 0.f;
#pragma unroll
                for (int c8 = 0; c8 < 8; ++c8) { const f32x4 ka = *(const f32x4*)(km + c8 * 8), kb2 = *(const f32x4*)(km + c8 * 8 + 4);
                    a += bf2f((unsigned short)q8[c8][0]) * ka.x + bf2f((unsigned short)q8[c8][1]) * ka.y + bf2f((unsigned short)q8[c8][2]) * ka.z + bf2f((unsigned short)q8[c8][3]) * ka.w;
                    a += bf2f((unsigned short)q8[c8][4]) * kb2.x + bf2f((unsigned short)q8[c8][5]) * kb2.y + bf2f((unsigned short)q8[c8][6]) * kb2.z + bf2f((unsigned short)q8[c8][7]) * kb2.w; }
                if (a > v0) { v2 = v1; i2 = i1; v1 = v0; i1 = i0; v0 = a; i0 = j; }
                else if (a > v1) { v2 = v1; i2 = i1; v1 = a; i1 = j; }
                else if (a > v2) { v2 = a; i2 = j; } }
            sel = (1u << i0) | (1u << i1) | (1u << i2);
        }
        float m = -INFINITY, l = 0.f;
        for (int jj = 0; jj <= blk; ++jj) {
            const int j = (jj == 0) ? blk : jj - 1;
            const bool act = (j == blk) || ((sel >> j) & 1u);
            if (!__any(act)) continue;
            const int kend = (j == blk) ? (s & 255) : 255;
            const bf16* kb = K + (size_t)(b * SEQ + j * MBLK) * AW + h * HD; const bf16* vb = V + (size_t)(b * SEQ + j * MBLK) * AW + h * HD;
#pragma unroll 1
            for (int k0 = 0; k0 < MBLK; ++k0) {
                const bf16x8* kp = (const bf16x8*)(kb + (size_t)k0 * AW); float a = 0.f;
#pragma unroll
                for (int c8 = 0; c8 < 8; ++c8) { const bf16x8 v = kp[c8];
#pragma unroll
                    for (int e = 0; e < 8; ++e) a += bf2f((unsigned short)q8[c8][e]) * bf2f((unsigned short)v[e]); }
                const float sc = (act && k0 <= kend) ? a : -INFINITY;
                if (sc > m) { const float corr = exp2f(m - sc); l *= corr;
#pragma unroll
                    for (int d = 0; d < 64; ++d) o[d] *= corr; m = sc; }
                const float p = exp2f(sc - m); l += p; const bf16x8* vp = (const bf16x8*)(vb + (size_t)k0 * AW);
#pragma unroll
                for (int c8 = 0; c8 < 8; ++c8) { const bf16x8 v = vp[c8];
#pragma unroll
                    for (int e = 0; e < 8; ++e) o[c8 * 8 + e] += p * bf2f((unsigned short)v[e]); }
            }
        }
        const float rl = 1.0f / l; u32x4* op = (u32x4*)(O + trow * AW + h * HD);
#pragma unroll
        for (int c8 = 0; c8 < 8; ++c8) { u32x4 w; w.x = pk2(o[c8 * 8 + 0] * rl, o[c8 * 8 + 1] * rl); w.y = pk2(o[c8 * 8 + 2] * rl, o[c8 * 8 + 3] * rl); w.z = pk2(o[c8 * 8 + 4] * rl, o[c8 * 8 + 5] * rl); w.w = pk2(o[c8 * 8 + 6] * rl, o[c8 * 8 + 7] * rl); op[c8] = w; }
    }
}

__device__ __forceinline__ void ph_branch_out_simple(Frame& F) {
    const bf16* AC = (const bf16*)(F.ws + WS_AC); const bf16* O = (const bf16*)(F.ws + WS_O);
    const bf16* GC = (const bf16*)(F.ws + WS_GC); const bf16* GA = (const bf16*)(F.ws + WS_GA);
    const bf16* Wco = (const bf16*)(F.ws + WS_WCO); const bf16* Wao = (const bf16*)(F.ws + WS_WAO); bf16* MX = (bf16*)(F.ws + WS_MIXED);
    float* tmp = F.out;
    constexpr int NTM = T / 128, NTN = D / 128;
    for (int it = F.vcu; it < NTM * NTN; it += F.G) {
        const int tm = it / NTN, tn = it % NTN;
        const bf16* A0 = AC + (size_t)tm * 128 * CW;
        sg_tile<false>([&](int r) { return A0 + (size_t)r * CW; }, Wco + (size_t)tn * 128 * CW, nullptr, CW, CW, F.wave, F.lane,
            [&](int r, int c, float v, float) { const size_t o = (size_t)(tm * 128 + r) * D + tn * 128 + c; tmp[o] = bf2f(GC[o]) * v; });
        const bf16* A1 = O + (size_t)tm * 128 * AW;
        sg_tile<false>([&](int r) { return A1 + (size_t)r * AW; }, Wao + (size_t)tn * 128 * AW, nullptr, AW, AW, F.wave, F.lane,
            [&](int r, int c, float v, float) { const size_t o = (size_t)(tm * 128 + r) * D + tn * 128 + c; MX[o] = (bf16)f2bf(tmp[o] + bf2f(GA[o]) * v); });
    }
}

__device__ __forceinline__ void ph_mix_simple(Frame& F) {
    const bf16* MX = (const bf16*)(F.ws + WS_MIXED); const bf16* W = (const bf16*)(F.ws + WS_WMIX); const float* x = F.in[0]; float* hp = F.out;
    constexpr int NTM = T / 128, NTN = D / 128;
    for (int it = F.vcu; it < NTM * NTN; it += F.G) {
        const int tm = it / NTN, tn = it % NTN;
        const bf16* A0 = MX + (size_t)tm * 128 * D;
        sg_tile<false>([&](int r) { return A0 + (size_t)r * D; }, W + (size_t)tn * 128 * D, nullptr, D, D, F.wave, F.lane,
            [&](int r, int c, float v, float) { const size_t o = (size_t)(tm * 128 + r) * D + tn * 128 + c; hp[o] = ALPHA * x[o] + v; });
    }
}

__device__ __forceinline__ void ph_ln1_simple(Frame& F) {
    const float* hp = F.out; const float* g = F.in[7]; const float* bta = F.in[8];
    bf16* HI = (bf16*)(F.ws + WS_H1HI); bf16* LO = (bf16*)(F.ws + WS_H1LO);
    const int gw = F.vcu * NWAVES + F.wave, NGW = F.G * NWAVES;
    for (int m = gw; m < T; m += NGW) {
        const f32x4* xr = (const f32x4*)(hp + (size_t)m * D) + F.lane;
        f32x4 v[4]; float s = 0.f;
#pragma unroll
        for (int j = 0; j < 4; ++j) { v[j] = xr[64 * j]; s += (v[j].x + v[j].y) + (v[j].z + v[j].w); }
        const float mean = wave_sum(s) * (1.f / D); float s2 = 0.f;
#pragma unroll
        for (int j = 0; j < 4; ++j) { v[j] = v[j] - mean; s2 += (v[j].x * v[j].x + v[j].y * v[j].y) + (v[j].z * v[j].z + v[j].w * v[j].w); }
        const float rstd = 1.f / sqrtf(wave_sum(s2) * (1.f / D) + LN_EPS);
#pragma unroll
        for (int j = 0; j < 4; ++j) { const int c = 4 * F.lane + 256 * j; const f32x4 gg = *(const f32x4*)(g + c), bb = *(const f32x4*)(bta + c);
            const f32x4 h = v[j] * rstd * gg + bb;
            u32x2 hi, lo; hi.x = pk2(h.x, h.y); hi.y = pk2(h.z, h.w);
            lo.x = pk2(h.x - bf2f(hi.x & 0xffffu), h.y - bf2f(hi.x >> 16)); lo.y = pk2(h.z - bf2f(hi.y & 0xffffu), h.w - bf2f(hi.y >> 16));
            *(u32x2*)(HI + (size_t)m * D + c) = hi; *(u32x2*)(LO + (size_t)m * D + c) = lo; }
    }
}

__device__ __forceinline__ void route_token(Frame& F, int t, f32x4 logit, const float* rbias) {
    const int lane = F.lane;
    int* CNT = (int*)(F.ws + WS_CTL) + CW_CNT; int* BIN = (int*)(F.ws + WS_BIN);
    int* TOPE = (int*)(F.ws + WS_TOPE); int* TOPP = (int*)(F.ws + WS_TOPP); float* TOPW = (float*)(F.ws + WS_TOPW);
    float sc[4], bs[4];
    const f32x4 rb = *(const f32x4*)(rbias + 4 * lane);
#pragma unroll
    for (int j = 0; j < 4; ++j) { sc[j] = sigmoidf_(logit[j]); bs[j] = sc[j] + rb[j]; }
    float m1 = fmaxf(bs[0], bs[1]), m2 = fminf(bs[0], bs[1]);
#pragma unroll
    for (int j = 2; j < 4; ++j) { const float v = bs[j]; m2 = fmaxf(m2, fminf(m1, v)); m1 = fmaxf(m1, v); }
#pragma unroll
    for (int o = 1; o < 8; o <<= 1) { const float o1 = __shfl_xor(m1, o), o2 = __shfl_xor(m2, o); const float n1 = fmaxf(m1, o1), n2 = fmaxf(fminf(m1, o1), fmaxf(m2, o2)); m1 = n1; m2 = n2; }
    const float gs = m1 + m2; const int myg = lane >> 3;
    int rank = 0;
#pragma unroll
    for (int g2 = 0; g2 < 8; ++g2) { const float og = __shfl(gs, g2 * 8); rank += (og > gs || (og == gs && g2 < myg)) ? 1 : 0; }
    const bool gsel = rank < TOPG;
    float mv[4];
#pragma unroll
    for (int j = 0; j < 4; ++j) mv[j] = gsel ? bs[j] : -INFINITY;
    int my_e = -1; float my_w = 0.f; float wsum = 0.f;
#pragma unroll 1
    for (int k = 0; k < TOPK; ++k) {
        float bv = mv[0]; int bi = 4 * lane;
#pragma unroll
        for (int j = 1; j < 4; ++j) if (mv[j] > bv) { bv = mv[j]; bi = 4 * lane + j; }
#pragma unroll
        for (int o = 1; o < 64; o <<= 1) { const float ov = __shfl_xor(bv, o); const int oi = __shfl_xor(bi, o); if (ov > bv || (ov == bv && oi < bi)) { bv = ov; bi = oi; } }
        const int ol = bi >> 2, oj = bi & 3;
        float sv = (oj == 0) ? sc[0] : (oj == 1) ? sc[1] : (oj == 2) ? sc[2] : sc[3];
        sv = __shfl(sv, ol);
        if (lane == ol) { if (oj == 0) mv[0] = -INFINITY; else if (oj == 1) mv[1] = -INFINITY; else if (oj == 2) mv[2] = -INFINITY; else mv[3] = -INFINITY; }
        if (lane == k) { my_e = bi; my_w = sv; }
        wsum += sv;
    }
    if (lane < TOPK) {
        const int pos = atomicAdd(&CNT[my_e], 1);
        BIN[(size_t)my_e * T + pos] = t;
        TOPE[t * TOPK + lane] = my_e; TOPP[t * TOPK + lane] = pos; TOPW[t * TOPK + lane] = my_w / wsum * RSCALE;
    }
}
__device__ __forceinline__ void ph_router_simple(Frame& F) {
    const bf16* HI = (const bf16*)(F.ws + WS_H1HI); const bf16* LO = (const bf16*)(F.ws + WS_H1LO);
    const float* Wr = F.in[9]; const float* rbias = F.in[10];
    const int gw = F.vcu * NWAVES + F.wave, NGW = F.G * NWAVES;
    for (int t0 = gw * 8; t0 < T; t0 += NGW * 8) {
        f32x4 acc[8];
#pragma unroll
        for (int i = 0; i < 8; ++i) acc[i] = (f32x4){0.f, 0.f, 0.f, 0.f};
        for (int k0 = 0; k0 < D; k0 += 64) {
            float hv[8];
#pragma unroll
            for (int i = 0; i < 8; ++i) { const size_t o = (size_t)(t0 + i) * D + k0 + F.lane; hv[i] = bf2f(HI[o]) + bf2f(LO[o]); }
#pragma unroll 8
            for (int kk = 0; kk < 64; ++kk) {
                const f32x4 w = *(const f32x4*)(Wr + (size_t)(k0 + kk) * NE + 4 * F.lane);
#pragma unroll
                for (int i = 0; i < 8; ++i) { const float hb = __builtin_bit_cast(float, __builtin_amdgcn_readlane(__builtin_bit_cast(int, hv[i]), kk)); acc[i] += w * hb; }
            }
        }
#pragma unroll
        for (int i = 0; i < 8; ++i) route_token(F, t0 + i, acc[i], rbias);
    }
}

template <int TR> __device__ __forceinline__ void build_tables(Frame& F, int* cnt, int* base, int* tb) {
    const int* CNT = (const int*)(F.ws + WS_CTL) + CW_CNT;
    __syncthreads();
    for (int e = F.tid; e < NE + 1; e += NTHR) cnt[e] = (e < NE) ? __hip_atomic_load(CNT + e, __ATOMIC_RELAXED, __HIP_MEMORY_SCOPE_AGENT) : T;
    __syncthreads();
    if (F.tid == 0) { int b = 0, t = 0; for (int e = 0; e <= NE; ++e) { base[e] = b; tb[e] = t; b += cnt[e]; t += (cnt[e] + TR - 1) / TR; } base[NE + 1] = b; tb[NE + 1] = t; }
    __syncthreads();
}
__device__ __forceinline__ int find_expert(const int* tb, int tile) {
    int lo = 0, hi = NE;
    while (lo < hi) { const int mid = (lo + hi + 1) >> 1; if (tb[mid] <= tile) lo = mid; else hi = mid - 1; }
    return lo;
}

__device__ __forceinline__ void ph_up_simple(Frame& F) {
    int* cnt = (int*)(F.lds); int* base = cnt + 320; int* tb = base + 320;
    build_tables<128>(F, cnt, base, tb);
    const bf16* HI = (const bf16*)(F.ws + WS_H1HI); const int* BIN = (const int*)(F.ws + WS_BIN);
    const bf16* W13 = (const bf16*)(F.ws + WS_W13T); bf16* HID = (bf16*)(F.ws + WS_HID);
    const int ntile = tb[NE + 1];
    for (int it = F.vcu; it < ntile * 2; it += F.G) {
        const int tile = it >> 1, pn = it & 1, e = find_expert(tb, tile), rt = tile - tb[e], ce = cnt[e], r0 = rt * 128;
        const int* bin = BIN + (size_t)e * T;
        const bf16* B1 = W13 + (size_t)e * 512 * 1024 + (size_t)(256 * pn) * 1024;
        sg_tile<true>([&](int r) { int rr = r0 + r; if (rr >= ce) rr = ce - 1; const int tok = (e < NE) ? bin[rr] : rr; return HI + (size_t)tok * D; },
            B1, B1 + (size_t)128 * 1024, 1024, D, F.wave, F.lane,
            [&](int r, int c, float v1, float v3) { if (r0 + r < ce) { const float hsw = v1 * sigmoidf_(v1) * v3; HID[(size_t)(base[e] + r0 + r) * ED + 128 * pn + c] = (bf16)f2bf(hsw); } });
    }
}
__device__ __forceinline__ void ph_down_simple(Frame& F) {
    int* cnt = (int*)(F.lds); int* base = cnt + 320; int* tb = base + 320;
    build_tables<128>(F, cnt, base, tb);
    const bf16* HID = (const bf16*)(F.ws + WS_HID); const bf16* W2 = (const bf16*)(F.ws + WS_W2T); bf16* Y = (bf16*)(F.ws + WS_Y);
    const int ntile = tb[NE + 1];
    for (int it = F.vcu; it < ntile * 8; it += F.G) {
        const int tile = it >> 3, pn = it & 7, e = find_expert(tb, tile), rt = tile - tb[e], ce = cnt[e], r0 = rt * 128;
        const bf16* A0 = HID + (size_t)base[e] * ED;
        sg_tile<false>([&](int r) { int rr = r0 + r; if (rr >= ce) rr = ce - 1; return A0 + (size_t)rr * ED; },
            W2 + (size_t)e * 1024 * 256 + (size_t)(128 * pn) * 256, nullptr, 256, ED, F.wave, F.lane,
            [&](int r, int c, float v, float) { if (r0 + r < ce) Y[(size_t)(base[e] + r0 + r) * D + 128 * pn + c] = (bf16)f2bf(v); });
    }
}
__device__ __forceinline__ void ph_final_simple(Frame& F) {
    int* cnt = (int*)(F.lds); int* base = cnt + 320; int* tb = base + 320;
    build_tables<128>(F, cnt, base, tb);
    const bf16* HI = (const bf16*)(F.ws + WS_H1HI); const bf16* LO = (const bf16*)(F.ws + WS_H1LO); const bf16* Y = (const bf16*)(F.ws + WS_Y);
    const int* TOPE = (const int*)(F.ws + WS_TOPE); const int* TOPP = (const int*)(F.ws + WS_TOPP); const float* TOPW = (const float*)(F.ws + WS_TOPW);
    const float* g = F.in[17]; const float* bta = F.in[18];
    const int gw = F.vcu * NWAVES + F.wave, NGW = F.G * NWAVES;
    for (int t = gw; t < T; t += NGW) {
        f32x4 v[4];
#pragma unroll
        for (int j = 0; j < 4; ++j) { const int c = 4 * F.lane + 256 * j; const u32x2 hi = *(const u32x2*)(HI + (size_t)t * D + c), lo = *(const u32x2*)(LO + (size_t)t * D + c);
            v[j].x = ALPHA * (bf2f(hi.x & 0xffffu) + bf2f(lo.x & 0xffffu)); v[j].y = ALPHA * (bf2f(hi.x >> 16) + bf2f(lo.x >> 16));
            v[j].z = ALPHA * (bf2f(hi.y & 0xffffu) + bf2f(lo.y & 0xffffu)); v[j].w = ALPHA * (bf2f(hi.y >> 16) + bf2f(lo.y >> 16)); }
        for (int k = 0; k <= TOPK; ++k) {
            int slot; float w;
            if (k < TOPK) { const int e = TOPE[t * TOPK + k]; slot = base[e] + TOPP[t * TOPK + k]; w = TOPW[t * TOPK + k]; } else { slot = NA + t; w = 1.0f; }
#pragma unroll
            for (int j = 0; j < 4; ++j) { const int c = 4 * F.lane + 256 * j; const u32x2 y = *(const u32x2*)(Y + (size_t)slot * D + c);
                v[j].x += w * bf2f(y.x & 0xffffu); v[j].y += w * bf2f(y.x >> 16); v[j].z += w * bf2f(y.y & 0xffffu); v[j].w += w * bf2f(y.y >> 16); }
        }
        float s = 0.f;
#pragma unroll
        for (int j = 0; j < 4; ++j) s += (v[j].x + v[j].y) + (v[j].z + v[j].w);
        const float mean = wave_sum(s) * (1.f / D); float s2 = 0.f;
#pragma unroll
        for (int j = 0; j < 4; ++j) { v[j] = v[j] - mean; s2 += (v[j].x * v[j].x + v[j].y * v[j].y) + (v[j].z * v[j].z + v[j].w * v[j].w); }
        const float rstd = 1.f / sqrtf(wave_sum(s2) * (1.f / D) + LN_EPS);
#pragma unroll
        for (int j = 0; j < 4; ++j) { const int c = 4 * F.lane + 256 * j; const f32x4 gg = *(const f32x4*)(g + c), bb = *(const f32x4*)(bta + c);
            *(f32x4*)(F.out + (size_t)t * D + c) = v[j] * rstd * gg + bb; }
    }
}

constexpr int N_PHASES = 13;
struct Args { const float* in[19]; float* out; unsigned char* ws; int ph_lo, ph_hi; };
__global__ void __launch_bounds__(NTHR, 2) fwd_kernel(Args args) {
    extern __shared__ __attribute__((aligned(16))) unsigned char lds[];
    Frame F;
    F.lds = lds; F.tid = threadIdx.x; F.lane = F.tid & 63; F.wave = __builtin_amdgcn_readfirstlane(F.tid >> 6);
    F.G = gridDim.x; { const int bx = blockIdx.x; F.vcu = (F.G % 8 == 0) ? (bx % 8) * (F.G / 8) + bx / 8 : bx; }
#pragma unroll
    for (int i = 0; i < 19; ++i) F.in[i] = args.in[i];
    F.out = args.out; F.ws = args.ws;
    volatile LAS unsigned* MISC = (volatile LAS unsigned*)((LAS unsigned char*)lds + MISC_OFF);
    if (F.tid < 32) MISC[F.tid] = 0u;
    __syncthreads();
#if MK_SINGLE
    XcdBarrier bar = xcd_barrier_post((unsigned*)(F.ws + WS_CTL) + CW_BAR, MISC + 8);
#define SEAM() xcd_barrier(bar)
#else
#define SEAM() do {} while (0)
#endif
    const int lo = args.ph_lo, hi = args.ph_hi;
#define IN(k) (lo <= (k) && (k) < hi)
#define BOTH(k) (IN(k) && IN((k) + 1))
    if (IN(0))  { ph_prologue(F);          if (BOTH(0))  SEAM(); }
    if (IN(1))  { ph_gemm1_simple(F);      if (BOTH(1))  SEAM(); }
    if (IN(2))  { ph_post1_simple(F);      if (BOTH(2))  SEAM(); }
    if (IN(3))  { ph_kmean_simple(F);      if (BOTH(3))  SEAM(); }
    if (IN(4))  { ph_attn_simple(F);       if (BOTH(4))  SEAM(); }
    if (IN(5))  { ph_branch_out_simple(F); if (BOTH(5))  SEAM(); }
    if (IN(6))  { ph_mix_simple(F);        if (BOTH(6))  SEAM(); }
    if (IN(7))  { ph_ln1_simple(F);        if (BOTH(7))  SEAM(); }
    if (IN(8))  { ph_router_simple(F);     if (BOTH(8))  SEAM(); }
    if (IN(9))  { ph_expert_weights(F);    if (BOTH(9))  SEAM(); }
    if (IN(10)) { ph_up_simple(F);         if (BOTH(10)) SEAM(); }
    if (IN(11)) { ph_down_simple(F);       if (BOTH(11)) SEAM(); }
    if (IN(12)) { ph_final_simple(F);      if (BOTH(12)) SEAM(); }
#undef IN
#undef BOTH
}

extern "C" void kernel_launch(void* const* d_in, const int* in_sizes, int n_in, void* d_out, int out_size, void* d_ws, size_t ws_size, hipStream_t stream) {
    static int grid = 0;
    if (grid == 0) {
        if (n_in != 19 || in_sizes[0] != T * D || out_size != T * D || ws_size < WS_END) { fprintf(stderr, "kernel_launch: unexpected shapes / workspace (n_in %d, ws %zu, need %zu); nothing launched\n", n_in, ws_size, (size_t)WS_END); grid = -1; return; }
        int dev = 0, cus = 0, per_cu = 0;
        if (hipGetDevice(&dev) != hipSuccess || hipDeviceGetAttribute(&cus, hipDeviceAttributeMultiprocessorCount, dev) != hipSuccess) { grid = -1; return; }
        if (hipFuncSetAttribute((const void*)fwd_kernel, hipFuncAttributeMaxDynamicSharedMemorySize, LDS_BYTES) != hipSuccess) { fprintf(stderr, "kernel_launch: hipFuncSetAttribute failed\n"); grid = -1; return; }
        if (hipOccupancyMaxActiveBlocksPerMultiprocessor(&per_cu, (const void*)fwd_kernel, NTHR, LDS_BYTES) != hipSuccess || per_cu < 1) { fprintf(stderr, "kernel_launch: occupancy query says %d blocks/CU\n", per_cu); per_cu = 1; }
        (void)hipGetLastError();
        grid = cus;
    }
    if (grid < 0) return;
    (void)hipMemsetAsync((char*)d_ws + WS_CTL, 0, CTL_BYTES, stream);
    Args a{};
    for (int i = 0; i < 19; ++i) a.in[i] = (const float*)d_in[i];
    a.out = (float*)d_out; a.ws = (unsigned char*)d_ws;
#if MK_SINGLE
    a.ph_lo = 0; a.ph_hi = N_PHASES;
    hipLaunchKernelGGL(fwd_kernel, dim3(grid), dim3(NTHR), LDS_BYTES, stream, a);
#else
    for (int p = 0; p < N_PHASES; ++p) { a.ph_lo = p; a.ph_hi = p + 1; hipLaunchKernelGGL(fwd_kernel, dim3(grid), dim3(NTHR), LDS_BYTES, stream, a); }
#endif
}
```

```cpp
#include <hip/hip_runtime.h>
#include <cstdio>
#include <cstdint>

#ifndef DUP_PHASE
#define DUP_PHASE -1
#endif
#ifndef MK_SINGLE
#define MK_SINGLE 1
#endif

constexpr int NB = 16, SEQ = 2048, T = NB * SEQ, D = 1024;
constexpr int CW = 1024, NH = 8, HD = 64, AW = 512, MBLK = 256, NBLK = SEQ / MBLK;
constexpr int INC = 3 * CW + 3 * AW + 2 * D;
constexpr int C_CB = 0, C_CC = 1024, C_CV = 2048, C_Q = 3072, C_K = 3584, C_V = 4096, C_GC = 4608, C_GA = 5632;
constexpr int NE = 256, TOPK = 8, NG = 8, TOPG = 4, ED = 256, SD = 256;
constexpr int NA = T * TOPK;
constexpr int NSLOT = NA + T;
constexpr float ALPHA = 1.189207115002721f, LN_EPS = 1e-5f, RSCALE = 2.5f;
constexpr float QSCALE = 0.125f * 1.4426950408889634f;
constexpr int NWAVES = 8, NTHR = 512;

constexpr size_t MiB = 1u << 20;
constexpr size_t WS_CTL = 0, CTL_BYTES = 1 * MiB;
constexpr size_t WS_KMEAN = 1 * MiB;
constexpr size_t WS_WIN = 2 * MiB;
constexpr size_t WS_WCO = 15 * MiB, WS_WAO = 17 * MiB, WS_WMIX = 18 * MiB, WS_WS13 = 20 * MiB, WS_WS2 = 21 * MiB;
constexpr size_t WS_ROPE = 1 * MiB + 512 * 1024;
constexpr size_t WS_UH = 24 * MiB, WS_CBH = 25 * MiB;
constexpr size_t WS_WR3 = 22 * MiB;
constexpr size_t WS_LOGITS = 718 * MiB;
constexpr size_t WS_TOPE = 24 * MiB, WS_TOPP = 25 * MiB, WS_TOPW = 26 * MiB;
constexpr size_t WS_H1HI = 28 * MiB, WS_H1LO = 92 * MiB;
constexpr size_t WS_W2T = 156 * MiB;
constexpr size_t WS_HID = 285 * MiB;
constexpr size_t WS_W13T = 429 * MiB;
constexpr size_t WS_BIN = 686 * MiB;
constexpr size_t WS_Y = 429 * MiB;
constexpr size_t WS_XB = 156 * MiB;
constexpr size_t WS_PROJ = 220 * MiB;
constexpr size_t WS_Q = 636 * MiB, WS_K = 668 * MiB, WS_V = 700 * MiB;
constexpr size_t WS_GC = 732 * MiB, WS_GA = 796 * MiB, WS_AC = 860 * MiB;
constexpr size_t WS_O = 924 * MiB;
constexpr size_t WS_MIXED = 956 * MiB;
constexpr size_t WS_END = 1020 * MiB;
constexpr int CW_TMO = 0, CW_CNT = 1024  , CW_BAR = 4096;

typedef unsigned short bf16;
typedef short bf16x8 __attribute__((ext_vector_type(8)));
typedef float f32x4 __attribute__((ext_vector_type(4)));
typedef unsigned u32x4 __attribute__((ext_vector_type(4)));
typedef unsigned u32x2 __attribute__((ext_vector_type(2)));
#define LAS __attribute__((address_space(3)))

__device__ __forceinline__ unsigned f2bf(float f) { unsigned u = __builtin_bit_cast(unsigned, f); return (u + 0x7fffu + ((u >> 16) & 1u)) >> 16; }
__device__ __forceinline__ float bf2f(unsigned h) { return __builtin_bit_cast(float, h << 16); }
__device__ __forceinline__ unsigned pk2(float lo, float hi) { return f2bf(lo) | (f2bf(hi) << 16); }
__device__ __forceinline__ float sigmoidf_(float x) { return 1.0f / (1.0f + __expf(-x)); }
__device__ __forceinline__ float wave_sum(float v) {
#pragma unroll
    for (int o = 1; o < 64; o <<= 1) v += __shfl_xor(v, o);
    return v;
}

struct Args { const float* in[19]; float* out; unsigned char* ws; int ph_lo, ph_hi; };
#define KARGS ((const __attribute__((address_space(4))) Args*)__builtin_amdgcn_kernarg_segment_ptr())
#define IN_PTR(k) (KARGS->in[k])
struct Frame {
    unsigned char* lds;
    int tid, lane, wave, vcu, G;
    float* out; unsigned char* ws;
};

template <class RMap>
__device__ __forceinline__ void transpose_item(const float* W, int K, int N, bf16* WT, RMap rmap, float* scr, int item, int lane) {
    const int nblk = N / 32, kb = item / nblk, nb = item % nblk, k0 = 64 * kb, n0 = 32 * nb;
#pragma unroll 8
    for (int i = 0; i < 32; ++i) { const int kk = 2 * i + (lane >> 5); scr[kk * 33 + (lane & 31)] = W[(size_t)(k0 + kk) * N + n0 + (lane & 31)]; }
    asm volatile("s_waitcnt vmcnt(0) lgkmcnt(0)" ::: "memory");
    const int c = lane & 7;
#pragma unroll
    for (int j = 0; j < 4; ++j) { const int n = (lane >> 3) + 8 * j; const float* s = scr + (8 * c) * 33 + n;
        u32x4 o; o.x = pk2(s[0 * 33], s[1 * 33]); o.y = pk2(s[2 * 33], s[3 * 33]); o.z = pk2(s[4 * 33], s[5 * 33]); o.w = pk2(s[6 * 33], s[7 * 33]);
        *(u32x4*)(WT + (size_t)rmap(n0 + n) * K + k0 + 8 * c) = o; }
    asm volatile("s_waitcnt vmcnt(0) lgkmcnt(0)" ::: "memory");
}
struct RMapId { int off; __device__ __forceinline__ int operator()(int n) const { return off + n; } };
struct RMap13 { int which; __device__ __forceinline__ int operator()(int n) const { return 256 * (n >> 7) + 128 * which + (n & 127); } };

struct RMapWin { __device__ __forceinline__ int operator()(int n) const {
    if (n < 3072 || (n >= 4608 && n < 5632)) { int role, c; if (n < 1024) { role = 0; c = n; } else if (n < 2048) { role = 1; c = n - 1024; } else if (n < 3072) { role = 2; c = n - 2048; } else { role = 3; c = n - 4608; }
        const int p = c >> 6, off = c & 63, wc = off >> 4, i = off & 15; return 256 * p + 128 * (role >> 1) + 32 * wc + 16 * (role & 1) + i; }
    if (n < 4608) { const int c = n - 3072, tile = 16 + (c >> 8), x = c & 255, hl = x >> 6, d = x & 63, dp = d & 31, fqh = dp >> 4, r = dp & 15, n_ = r >> 3, r2 = r & 7, fql = r2 >> 2, j = r2 & 3;
        return 256 * tile + 128 * (hl >> 1) + 32 * (2 * (hl & 1) + (d >> 5)) + 16 * n_ + 4 * (2 * fqh + fql) + j; }
    const int c = n - 5632, tile = 22 + (c >> 8), x = c & 255, w = x & 31, rho = 16 * ((w & 7) >> 2) + 4 * (w >> 3) + (w & 3); return 256 * tile + (x & ~31) + rho; } };

template <bool DUAL, class ARow, class Epi>
__device__ __forceinline__ void sg_tile(ARow arow, const bf16* Bt, const bf16* Bt2, size_t ldb, int K, int wave, int lane, Epi epi) {
    const int wr = wave >> 1, wc = wave & 1, fr = lane & 15, fq = lane >> 4;
    f32x4 acc[2][4], acc2[2][4];
#pragma unroll
    for (int i = 0; i < 2; ++i)
#pragma unroll
        for (int j = 0; j < 4; ++j) { acc[i][j] = (f32x4){0.f, 0.f, 0.f, 0.f}; acc2[i][j] = (f32x4){0.f, 0.f, 0.f, 0.f}; }
    const bf16* ap[2]; const bf16* bp[4]; const bf16* bp2[4];
#pragma unroll
    for (int i = 0; i < 2; ++i) ap[i] = arow(32 * wr + 16 * i + fr) + 8 * fq;
#pragma unroll
    for (int j = 0; j < 4; ++j) { bp[j] = Bt + (size_t)(64 * wc + 16 * j + fr) * ldb + 8 * fq; bp2[j] = DUAL ? Bt2 + (size_t)(64 * wc + 16 * j + fr) * ldb + 8 * fq : bp[j]; }
    for (int k0 = 0; k0 < K; k0 += 32) {
        bf16x8 a[2], b[4], b2[4];
#pragma unroll
        for (int i = 0; i < 2; ++i) a[i] = *(const bf16x8*)(ap[i] + k0);
#pragma unroll
        for (int j = 0; j < 4; ++j) { b[j] = *(const bf16x8*)(bp[j] + k0); if (DUAL) b2[j] = *(const bf16x8*)(bp2[j] + k0); }
#pragma unroll
        for (int i = 0; i < 2; ++i)
#pragma unroll
            for (int j = 0; j < 4; ++j) { acc[i][j] = __builtin_amdgcn_mfma_f32_16x16x32_bf16(a[i], b[j], acc[i][j], 0, 0, 0);
                if (DUAL) acc2[i][j] = __builtin_amdgcn_mfma_f32_16x16x32_bf16(a[i], b2[j], acc2[i][j], 0, 0, 0); }
    }
#pragma unroll
    for (int i = 0; i < 2; ++i)
#pragma unroll
        for (int j = 0; j < 4; ++j)
#pragma unroll
            for (int r = 0; r < 4; ++r) epi(32 * wr + 16 * i + 4 * fq + r, 64 * wc + 16 * j + fr, acc[i][j][r], acc2[i][j][r]);
}

namespace pg8 {
#define PG8_LAS __attribute__((address_space(3)))
typedef unsigned short bf16_t;
typedef short bf16x8 __attribute__((ext_vector_type(8)));
typedef float f32x4 __attribute__((ext_vector_type(4)));
typedef unsigned u32x4 __attribute__((ext_vector_type(4)));
typedef unsigned u32x2v __attribute__((ext_vector_type(2)));
constexpr int BM = 256, BK = 64, HALF = 128, HTB = HALF * BK * 2  , STAGE_BYTES = 8 * HTB, NXCD = 8, WGM = 8;

__host__ __device__ __forceinline__ int lds_byte(int r, int c) { const int st = (r >> 4) * 2 + (c >> 5), rr = r & 15, cc = c & 31, ob = rr * 64 + cc * 2; return st * 1024 + (ob ^ (((ob >> 9) & 1) << 5)); }
__host__ __device__ __forceinline__ void stage_rc(int b, int& R, int& C) { const int st = b / 1024, sb = b % 1024, swz = sb ^ (((sb >> 9) & 1) << 5); R = (st >> 1) * 16 + swz / 64; C = (st & 1) * 32 + (swz % 64) / 2; }
__host__ __device__ __forceinline__ int perm32(int rho) { const int n = rho >> 4, i = rho & 15; return 8 * (i >> 2) + 4 * n + (i & 3); }

struct Unit { int pm, pn; };
struct Gemm { const bf16_t* A; const bf16_t* Bt; int M, N, K; };

struct StaticOrder {
    int nM, nN, nwg, G, c;
    __host__ __device__ void init(int M, int N, int G_, int c_) { nM = M / BM; nN = N / BM; nwg = nM * nN; G = G_; c = c_; }
    __host__ __device__ bool next(int i, Unit& u) const {
        const long L = (long)i * G + c; if (L >= nwg) return false;
        int wgid = (int)L; { const int q = nwg / NXCD, r = nwg % NXCD, xcd = wgid % NXCD, off = wgid / NXCD; wgid = (xcd < r ? xcd * (q + 1) : r * (q + 1) + (xcd - r) * q) + off; }
        const int nig = WGM * nN, gid = wgid / nig, fm = gid * WGM, gsz = (nM - fm) < WGM ? (nM - fm) : WGM;
        u.pm = fm + ((wgid % nig) % gsz); u.pn = (wgid % nig) / gsz; return true;
    }
    __device__ __forceinline__ void a_ready(const Unit&) const {}
    __device__ __forceinline__ void done(const Unit&) const {}
};

typedef float f32x2c __attribute__((ext_vector_type(2))); typedef __bf16 bf16x2c __attribute__((ext_vector_type(2)));
__device__ __forceinline__ unsigned cvt_pk_bf16(float lo, float hi) { const f32x2c v = {lo, hi}; const bf16x2c b = __builtin_convertvector(v, bf16x2c); return __builtin_bit_cast(unsigned, b); }
typedef float f32x2 __attribute__((ext_vector_type(2)));
__device__ __forceinline__ f32x2 gelu_pk(f32x2 v) {
    const f32x2 av = __builtin_elementwise_abs(v), d = av * 0.2316418882f + 1.0f;
    f32x2 t; t.x = __builtin_amdgcn_rcpf(d.x); t.y = __builtin_amdgcn_rcpf(d.y);
    f32x2 q = t * 0.5307027145f + (-0.7265760135f); q = q * t + 0.7107068705f; q = q * t + (-0.142248368f); q = q * t + 0.127414796f; q = q * t;
    const f32x2 s = (v * v) * (-0.72134752044f);
    f32x2 e; e.x = __builtin_amdgcn_exp2f(s.x); e.y = __builtin_amdgcn_exp2f(s.y);
    const f32x2 m = v * (q * e), r = v - m;
    f32x2 o; o.x = v.x < 0.f ? m.x : r.x; o.y = v.y < 0.f ? m.y : r.y; return o;
}

template <int ACT  > struct EpiBf16 {
    static constexpr bool PERM = true, AFTER_DRAIN = false; static_assert(ACT == 0 || ACT == 1, "EpiBf16: ACT is 0 (none) or 1 (gelu_pk)");
    bf16_t* O; int ldc; const float* bias; int split_cols; size_t split_stride; float scale0;
    __device__ __forceinline__ void operator()(const f32x4 (&acc)[2][2][4][2], const Unit& u, int wr, int wc, int fr, int fq) const {
        const int row0 = u.pm * BM + wr * 64 + fr; int colt = u.pn * BM; bf16_t* base = O;
        float sc = 1.f; if (split_cols) { const int t = colt / split_cols; base += (size_t)t * split_stride; colt -= t * split_cols; if (t == 0) sc = scale0; }
        const int col0 = colt + wc * 32 + 8 * fq, bcol0 = u.pn * BM + wc * 32 + 8 * fq;
        f32x4 bv[2][2];
#pragma unroll
        for (int bj = 0; bj < 2; ++bj)
#pragma unroll
            for (int n = 0; n < 2; ++n) bv[bj][n] = bias ? *(const f32x4*)(bias + bcol0 + bj * HALF + 4 * n) : (f32x4){0.f, 0.f, 0.f, 0.f};
#pragma unroll
        for (int ai = 0; ai < 2; ++ai)
#pragma unroll
            for (int m = 0; m < 4; ++m) { bf16_t* rowp = base + (size_t)(row0 + ai * HALF + m * 16) * ldc + col0;
#pragma unroll
                for (int bj = 0; bj < 2; ++bj) { f32x4 v0 = acc[ai][bj][m][0] + bv[bj][0], v1 = acc[ai][bj][m][1] + bv[bj][1];
                    if (ACT == 1) { f32x2 a = gelu_pk((f32x2){v0[0], v0[1]}), b = gelu_pk((f32x2){v0[2], v0[3]}), c = gelu_pk((f32x2){v1[0], v1[1]}), d = gelu_pk((f32x2){v1[2], v1[3]});
                        v0 = (f32x4){a.x, a.y, b.x, b.y}; v1 = (f32x4){c.x, c.y, d.x, d.y}; }
                    v0 = v0 * sc; v1 = v1 * sc; u32x4 w; w.x = cvt_pk_bf16(v0[0], v0[1]); w.y = cvt_pk_bf16(v0[2], v0[3]); w.z = cvt_pk_bf16(v1[0], v1[1]); w.w = cvt_pk_bf16(v1[2], v1[3]);
                    *(u32x4*)(rowp + bj * HALF) = w; } }
    }
};

struct PanelStats {
    unsigned* xbuf;
    unsigned* cnt;
    unsigned* tmo;
    int ntn; float eps;
    unsigned code;
    __device__ __forceinline__ bool run(const f32x4 (&v)[2][2][4][2], const Unit& u, int wr, int wc, int fr, int fq, PG8_LAS unsigned char* lds, int wid, int lane) const {
        typedef float f32x2v __attribute__((ext_vector_type(2)));
        PG8_LAS f32x2v* P = (PG8_LAS f32x2v*)lds;
        PG8_LAS f32x2v* S = (PG8_LAS f32x2v*)(lds + 8192);
        PG8_LAS unsigned* flag = (PG8_LAS unsigned*)(lds + 8192 + 2048);
#pragma unroll
        for (int ai = 0; ai < 2; ++ai)
#pragma unroll
            for (int m = 0; m < 4; ++m) {
                float s = 0.f;
#pragma unroll
                for (int bj = 0; bj < 2; ++bj)
#pragma unroll
                    for (int n = 0; n < 2; ++n) { const f32x4 x = v[ai][bj][m][n]; s += (x[0] + x[1]) + (x[2] + x[3]); }
                s += __shfl_xor(s, 16); s += __shfl_xor(s, 32);
                const float mw = s * (1.0f / 64.0f); float q = 0.f;
#pragma unroll
                for (int bj = 0; bj < 2; ++bj)
#pragma unroll
                    for (int n = 0; n < 2; ++n) { const f32x4 d = v[ai][bj][m][n] - mw; q += (d[0] * d[0] + d[1] * d[1]) + (d[2] * d[2] + d[3] * d[3]); }
                q += __shfl_xor(q, 16); q += __shfl_xor(q, 32);
                if (fq == 0) P[(ai * HALF + wr * 64 + m * 16 + fr) * 4 + wc] = (f32x2v){mw, q};
            }
        asm volatile("s_waitcnt lgkmcnt(0)" ::: "memory"); __builtin_amdgcn_s_barrier(); asm volatile("" ::: "memory");
#if defined(BROKEN_EXCHANGE_NO_WAIT)
#warning BROKEN CONTROL BUILD: the row-statistics exchange does not wait; results are wrong by design
        if (blockIdx.x >= 64) { const long long t0_ = clock64(); while (clock64() - t0_ < 60000) __builtin_amdgcn_s_sleep(8); }
#endif
        const int row = wid * 32 + (lane & 31);
        if (lane < 32) {
            const f32x2v a = P[row * 4 + 0], b = P[row * 4 + 1], c = P[row * 4 + 2], d = P[row * 4 + 3];
            const float mt = (a.x + b.x + c.x + d.x) * 0.25f;
            const float da = a.x - mt, db = b.x - mt, dc = c.x - mt, dd = d.x - mt;
            const float m2 = (a.y + b.y) + (c.y + d.y) + 64.0f * ((da * da + db * db) + (dc * dc + dd * dd));
            unsigned long long* slot = (unsigned long long*)xbuf + ((size_t)(u.pm * BM + row) * 4 + u.pn);
            __hip_atomic_store(slot, ((unsigned long long)__float_as_uint(m2) << 32) | __float_as_uint(mt), __ATOMIC_RELAXED, __HIP_MEMORY_SCOPE_AGENT);
        }
        asm volatile("s_waitcnt vmcnt(0)" ::: "memory");
        if (lane == 0) __hip_atomic_fetch_add(cnt + 64 * u.pm, 1u, __ATOMIC_RELAXED, __HIP_MEMORY_SCOPE_AGENT);
        if (wid == 0) {
            bool dead = false; const unsigned long long t0 = __builtin_amdgcn_s_memrealtime(); const unsigned want = 8u * (unsigned)ntn;
            for (;;) {
#if defined(BROKEN_EXCHANGE_NO_WAIT)
                break;
#endif
                if ((unsigned)__builtin_amdgcn_readfirstlane(__hip_atomic_load(cnt + 64 * u.pm, __ATOMIC_RELAXED, __HIP_MEMORY_SCOPE_AGENT)) >= want) break;
                if (__builtin_amdgcn_s_memrealtime() - t0 > 2000000ull) {
                    if (lane == 0) { unsigned expect = 0u; __hip_atomic_compare_exchange_strong(tmo + 1, &expect, code | (unsigned)(u.pm & 0xff), __ATOMIC_RELAXED, __ATOMIC_RELAXED, __HIP_MEMORY_SCOPE_AGENT);
                                     __hip_atomic_store(tmo, 1u, __ATOMIC_RELAXED, __HIP_MEMORY_SCOPE_AGENT); }
                    dead = true; break; }
                __builtin_amdgcn_s_sleep(2);
            }
            __builtin_amdgcn_fence(__ATOMIC_ACQUIRE, "agent");
            if (lane == 0) flag[0] = dead ? 1u : 0u;
        }
        asm volatile("s_waitcnt vmcnt(0) lgkmcnt(0)" ::: "memory"); __builtin_amdgcn_s_barrier(); asm volatile("" ::: "memory");
        const bool bad = flag[0] != 0u;
        if (lane < 32) {
            const unsigned long long* slot = (const unsigned long long*)xbuf + (size_t)(u.pm * BM + row) * 4; float mt[4], m2[4]; float ms = 0.f;
#pragma unroll
            for (int t = 0; t < 4; ++t) { if (t < ntn) { const unsigned long long w = __hip_atomic_load(slot + t, __ATOMIC_RELAXED, __HIP_MEMORY_SCOPE_AGENT); mt[t] = __uint_as_float((unsigned)w); m2[t] = __uint_as_float((unsigned)(w >> 32)); } else { mt[t] = 0.f; m2[t] = 0.f; } ms += mt[t]; }
            const float mean = ms / (float)ntn; float q = 0.f;
#pragma unroll
            for (int t = 0; t < 4; ++t) if (t < ntn) { const float dm = mt[t] - mean; q += m2[t] + 256.0f * dm * dm; }
            S[row] = (f32x2v){mean, 1.0f / sqrtf(q / (256.0f * (float)ntn) + eps)};
        }
        asm volatile("s_waitcnt lgkmcnt(0)" ::: "memory"); __builtin_amdgcn_s_barrier(); asm volatile("" ::: "memory");
        return bad;
    }
};
struct EpiLnRes {
    static constexpr bool PERM = false, AFTER_DRAIN = true;
    const float* base; float* out; int ldc; const float* bias; PanelStats st; unsigned poison;
    __device__ __forceinline__ void fused(f32x4 (&acc)[2][2][4][2], const Unit& u, int wr, int wc, int fr, int fq, PG8_LAS unsigned char* lds, int wid, int lane) const {
        typedef float f32x2v __attribute__((ext_vector_type(2)));
        const PG8_LAS f32x2v* S = (const PG8_LAS f32x2v*)(lds + 8192);
        const int col0 = u.pn * BM + wc * 32 + 4 * fq;
#pragma unroll
        for (int bj = 0; bj < 2; ++bj)
#pragma unroll
            for (int n = 0; n < 2; ++n) { const f32x4 bv = bias ? *(const f32x4*)(bias + col0 + bj * HALF + n * 16) : (f32x4){0.f, 0.f, 0.f, 0.f};
#pragma unroll
                for (int ai = 0; ai < 2; ++ai)
#pragma unroll
                    for (int m = 0; m < 4; ++m) acc[ai][bj][m][n] += bv; }
        f32x4 pre[4][2][2];
#pragma unroll
        for (int m = 0; m < 4; ++m) { const size_t off = (size_t)(u.pm * BM + wr * 64 + m * 16 + fr) * ldc + col0;
#pragma unroll
            for (int bj = 0; bj < 2; ++bj)
#pragma unroll
                for (int n = 0; n < 2; ++n) pre[m][bj][n] = *(const f32x4*)(base + off + bj * HALF + n * 16); }
        const bool bad = st.run(acc, u, wr, wc, fr, fq, lds, wid, lane) || poison != 0u;
        const float qnan = __builtin_nanf("");
#pragma unroll
        for (int ai = 0; ai < 2; ++ai)
#pragma unroll
            for (int m = 0; m < 4; ++m) { const int r = ai * HALF + wr * 64 + m * 16 + fr; const f32x2v sr = S[r]; const size_t off = (size_t)(u.pm * BM + r) * ldc + col0;
#pragma unroll
                for (int bj = 0; bj < 2; ++bj)
#pragma unroll
                    for (int n = 0; n < 2; ++n) { const f32x4 bs = ai == 0 ? pre[m][bj][n] : *(const f32x4*)(base + off + bj * HALF + n * 16); f32x4 o = bs + (acc[ai][bj][m][n] - sr.x) * sr.y;
                        if (bad) o = (f32x4){qnan, qnan, qnan, qnan}; *(f32x4*)(out + off + bj * HALF + n * 16) = o; }
                if (m & 1) asm volatile("" ::: "memory"); }
    }
};
struct EpiLnResLn {
    static constexpr bool PERM = false, AFTER_DRAIN = true;
    const float* base; float* out; bf16_t* xn; int ldc; const float* bias; PanelStats st1, st2; unsigned poison;
    __device__ __forceinline__ void fused(f32x4 (&acc)[2][2][4][2], const Unit& u, int wr, int wc, int fr, int fq, PG8_LAS unsigned char* lds, int wid, int lane) const {
        typedef float f32x2v __attribute__((ext_vector_type(2))); typedef unsigned u32x2v __attribute__((ext_vector_type(2)));
        const PG8_LAS f32x2v* S = (const PG8_LAS f32x2v*)(lds + 8192);
        const int col0 = u.pn * BM + wc * 32 + 4 * fq;
#pragma unroll
        for (int bj = 0; bj < 2; ++bj)
#pragma unroll
            for (int n = 0; n < 2; ++n) { const f32x4 bv = bias ? *(const f32x4*)(bias + col0 + bj * HALF + n * 16) : (f32x4){0.f, 0.f, 0.f, 0.f};
#pragma unroll
                for (int ai = 0; ai < 2; ++ai)
#pragma unroll
                    for (int m = 0; m < 4; ++m) acc[ai][bj][m][n] += bv; }
        bool bad = st1.run(acc, u, wr, wc, fr, fq, lds, wid, lane) || poison != 0u;
        const float qnan = __builtin_nanf("");
#pragma unroll
        for (int ai = 0; ai < 2; ++ai)
#pragma unroll
            for (int m = 0; m < 4; ++m) { const int r = ai * HALF + wr * 64 + m * 16 + fr; const f32x2v sr = S[r]; const size_t off = (size_t)(u.pm * BM + r) * ldc + col0;
#pragma unroll
                for (int bj = 0; bj < 2; ++bj)
#pragma unroll
                    for (int n = 0; n < 2; ++n) { const f32x4 bs = *(const f32x4*)(base + off + bj * HALF + n * 16); acc[ai][bj][m][n] = bs + (acc[ai][bj][m][n] - sr.x) * sr.y; }
                asm volatile("" : "+v"(acc[ai][0][m][0]), "+v"(acc[ai][0][m][1]), "+v"(acc[ai][1][m][0]), "+v"(acc[ai][1][m][1]));
                if (m & 1) asm volatile("" ::: "memory"); }
        const bool bad1 = bad;
        bad = st2.run(acc, u, wr, wc, fr, fq, lds, wid, lane) || bad;
#pragma unroll
        for (int ai = 0; ai < 2; ++ai)
#pragma unroll
            for (int m = 0; m < 4; ++m) { const int r = ai * HALF + wr * 64 + m * 16 + fr; const f32x2v sr = S[r]; const size_t off = (size_t)(u.pm * BM + r) * ldc + col0;
#pragma unroll
                for (int bj = 0; bj < 2; ++bj)
#pragma unroll
                    for (int n = 0; n < 2; ++n) { const f32x4 x1 = acc[ai][bj][m][n]; *(f32x4*)(out + off + bj * HALF + n * 16) = bad1 ? (f32x4){qnan, qnan, qnan, qnan} : x1;
                        const f32x4 o = (x1 - sr.x) * sr.y; u32x2v w; w.x = cvt_pk_bf16(o[0], o[1]); w.y = cvt_pk_bf16(o[2], o[3]);
                        if (bad) { w.x = 0x7fc07fc0u; w.y = 0x7fc07fc0u; } *(u32x2v*)(xn + off + bj * HALF + n * 16) = w; }
                asm volatile("" ::: "memory"); }
    }
};

template <class Epi, class Sched, bool ALIGN_EPI = false, bool SP2 = false>
__device__ __forceinline__ void gemm_phase(PG8_LAS unsigned char* lds, const Gemm g, const Sched& S, const Epi& E) {
    const int tid = threadIdx.x, wid = __builtin_amdgcn_readfirstlane(tid >> 6), lane = tid & 63, wr = wid >> 2, wc = wid & 3, fr = lane & 15, fq = lane >> 4;
    const int K = g.K, nt = K / BK;
    unsigned voffA[2], voffB[2];
#pragma unroll
    for (int i = 0; i < 2; ++i) { int R, C; stage_rc(tid * 16 + i * 8192, R, C); const int Rb = Epi::PERM ? ((R & ~31) + perm32(R & 31)) : R;
        voffA[i] = (unsigned)(R * K + C) * 2u; voffB[i] = (unsigned)(Rb * K + C) * 2u; }
    const size_t kstep = (size_t)(BK * 2);
    const size_t hstep = (size_t)HALF * K * 2;
    const size_t tstep = 2 * hstep;
    const unsigned ldsw = (unsigned)wid * 1024u;
    const int aoff = lds_byte(wr * 64 + fr, fq * 8), boff = lds_byte(wc * 32 + fr, fq * 8);
#define PG8_SA(b, h) (((b) * 2 + (h)) * HTB)
#define PG8_SB(b, h) ((4 + (b) * 2 + (h)) * HTB)
#define PG8_STAGE(bufoff, gbase, voff) do { _Pragma("unroll") for (int _i = 0; _i < 2; ++_i) \
        __builtin_amdgcn_global_load_lds((const unsigned*)((const char*)(gbase) + (voff)[_i]), (PG8_LAS unsigned*)(lds + (bufoff) + ldsw + _i * 8192), 16, 0, 0); } while (0)
#define PG8_LDA(dst, b, h) do { _Pragma("unroll") for (int m = 0; m < 4; ++m) _Pragma("unroll") for (int k = 0; k < 2; ++k) dst[m][k] = *(const PG8_LAS bf16x8*)(lds + PG8_SA(b, h) + aoff + m * 2048 + k * 1024); } while (0)
#define PG8_LDB(dst, b, h) do { _Pragma("unroll") for (int n = 0; n < 2; ++n) _Pragma("unroll") for (int k = 0; k < 2; ++k) dst[n][k] = *(const PG8_LAS bf16x8*)(lds + PG8_SB(b, h) + boff + n * 2048 + k * 1024); } while (0)
#define PG8_MMA(ai, bj, At, Bt) do { __builtin_amdgcn_s_setprio(1); _Pragma("unroll") for (int m = 0; m < 4; ++m) _Pragma("unroll") for (int n = 0; n < 2; ++n) _Pragma("unroll") for (int k = 0; k < 2; ++k) \
        acc[ai][bj][m][n] = __builtin_amdgcn_mfma_f32_16x16x32_bf16(Bt[n][k], At[m][k], acc[ai][bj][m][n], 0, 0, 0); __builtin_amdgcn_s_setprio(0); } while (0)
#define PG8_WAIT_V(n) asm volatile("s_waitcnt vmcnt(" #n ")" ::: "memory")
#define PG8_WAIT_L(n) asm volatile("s_waitcnt lgkmcnt(" #n ")" ::: "memory")
#define PG8_BAR __builtin_amdgcn_s_barrier()
#define PG8_SCHED __builtin_amdgcn_sched_barrier(0)
    Unit cur, nxt; int ui = 0;
    if (!S.next(0, cur)) return;
    f32x4 acc[2][2][4][2];
#pragma unroll
    for (int a = 0; a < 2; ++a)
#pragma unroll
        for (int b = 0; b < 2; ++b)
#pragma unroll
            for (int m = 0; m < 4; ++m)
#pragma unroll
                for (int n = 0; n < 2; ++n) acc[a][b][m][n] = (f32x4){0.f, 0.f, 0.f, 0.f};
    bf16x8 At[4][2], B0[2][2], B1[2][2];
    const char* cA = (const char*)g.A + (size_t)cur.pm * tstep; const char* cB = (const char*)g.Bt + (size_t)cur.pn * tstep;
    S.a_ready(cur);
    if constexpr (SP2) {
        PG8_STAGE(PG8_SB(0, 0), cB, voffB); PG8_STAGE(PG8_SB(0, 1), cB + hstep, voffB); PG8_STAGE(PG8_SA(0, 0), cA, voffA); PG8_STAGE(PG8_SA(0, 1), cA + hstep, voffA);
        if (wr == 1) PG8_BAR;
        PG8_WAIT_V(2); PG8_BAR;
        PG8_STAGE(PG8_SB(1, 0), cB + kstep, voffB); PG8_STAGE(PG8_SA(1, 0), cA + kstep, voffA); PG8_STAGE(PG8_SB(1, 1), cB + hstep + kstep, voffB);
        PG8_WAIT_V(6); PG8_BAR;
    } else {
        PG8_STAGE(PG8_SB(0, 0), cB, voffB); PG8_STAGE(PG8_SA(0, 0), cA, voffA); PG8_STAGE(PG8_SB(0, 1), cB + hstep, voffB); PG8_STAGE(PG8_SA(0, 1), cA + hstep, voffA);
        if (wr == 1) PG8_BAR;
        PG8_WAIT_V(4); PG8_BAR;
        PG8_STAGE(PG8_SB(1, 0), cB + kstep, voffB); PG8_STAGE(PG8_SA(1, 0), cA + kstep, voffA); PG8_STAGE(PG8_SB(1, 1), cB + hstep + kstep, voffB);
        PG8_WAIT_V(6); PG8_BAR;
    }
    for (;;) {
        const bool has_next = S.next(ui + 1, nxt);
        const char* nA = has_next ? (const char*)g.A + (size_t)nxt.pm * tstep : cA; const char* nB = has_next ? (const char*)g.Bt + (size_t)nxt.pn * tstep : cB;
        for (int t = 0; t < nt; t += 2) {
            const bool last = (t == nt - 2);
            const char* a1 = cA + (size_t)(t + 1) * kstep;
            const char* a2 = last ? nA : cA + (size_t)(t + 2) * kstep; const char* b2 = last ? nB : cB + (size_t)(t + 2) * kstep;
            const char* a3 = a2 + kstep; const char* b3 = b2 + kstep;
            if (last && has_next) S.a_ready(nxt);
            if constexpr (SP2) {
            PG8_LDB(B0, 0, 0); PG8_LDB(B1, 0, 1); PG8_SCHED; PG8_LDA(At, 0, 0); PG8_STAGE(PG8_SA(1, 1), a1 + hstep, voffA);
            PG8_WAIT_V(8); PG8_WAIT_L(0); PG8_BAR; PG8_MMA(0, 0, At, B0); PG8_MMA(0, 1, At, B1); PG8_BAR; PG8_SCHED;
            PG8_LDA(At, 0, 1); PG8_STAGE(PG8_SB(0, 0), b2, voffB); PG8_STAGE(PG8_SB(0, 1), b2 + hstep, voffB); PG8_STAGE(PG8_SA(0, 0), a2, voffA);
            PG8_WAIT_V(8); PG8_WAIT_L(0); PG8_BAR; PG8_MMA(1, 0, At, B0); PG8_MMA(1, 1, At, B1); PG8_BAR; PG8_SCHED;
            PG8_LDB(B0, 1, 0); PG8_LDB(B1, 1, 1); PG8_SCHED; PG8_LDA(At, 1, 0); PG8_STAGE(PG8_SA(0, 1), a2 + hstep, voffA);
            PG8_WAIT_V(8); PG8_WAIT_L(0); PG8_BAR; PG8_MMA(0, 0, At, B0); PG8_MMA(0, 1, At, B1); PG8_BAR; PG8_SCHED;
            PG8_LDA(At, 1, 1); PG8_STAGE(PG8_SB(1, 0), b3, voffB); PG8_STAGE(PG8_SB(1, 1), b3 + hstep, voffB); PG8_STAGE(PG8_SA(1, 0), a3, voffA);
            PG8_WAIT_V(8); PG8_WAIT_L(0); PG8_BAR; PG8_MMA(1, 0, At, B0); PG8_MMA(1, 1, At, B1); PG8_BAR; PG8_SCHED;
            } else {
            PG8_LDB(B0, 0, 0); PG8_SCHED; PG8_LDA(At, 0, 0); PG8_STAGE(PG8_SA(1, 1), a1 + hstep, voffA);
            PG8_WAIT_L(8); PG8_BAR; PG8_WAIT_L(0); PG8_MMA(0, 0, At, B0); PG8_BAR; PG8_SCHED;
            PG8_LDB(B1, 0, 1); PG8_STAGE(PG8_SB(0, 0), b2, voffB);
            PG8_BAR; PG8_WAIT_L(0); PG8_MMA(0, 1, At, B1); PG8_BAR;
            PG8_LDA(At, 0, 1); PG8_STAGE(PG8_SA(0, 0), a2, voffA);
            PG8_BAR; PG8_WAIT_L(0); PG8_MMA(1, 0, At, B0); PG8_BAR; PG8_SCHED;
            PG8_STAGE(PG8_SB(0, 1), b2 + hstep, voffB);
            PG8_WAIT_V(6); PG8_BAR; PG8_MMA(1, 1, At, B1); PG8_BAR;
            PG8_LDB(B0, 1, 0); PG8_SCHED; PG8_LDA(At, 1, 0); PG8_STAGE(PG8_SA(0, 1), a2 + hstep, voffA);
            PG8_WAIT_L(8); PG8_BAR; PG8_WAIT_L(0); PG8_MMA(0, 0, At, B0); PG8_BAR; PG8_SCHED;
            PG8_LDB(B1, 1, 1); PG8_STAGE(PG8_SB(1, 0), b3, voffB);
            PG8_BAR; PG8_WAIT_L(0); PG8_MMA(0, 1, At, B1); PG8_BAR;
            PG8_LDA(At, 1, 1); PG8_STAGE(PG8_SA(1, 0), a3, voffA);
            PG8_BAR; PG8_WAIT_L(0); PG8_MMA(1, 0, At, B0); PG8_BAR; PG8_SCHED;
            PG8_STAGE(PG8_SB(1, 1), b3 + hstep, voffB);
            PG8_WAIT_V(6); PG8_BAR; PG8_MMA(1, 1, At, B1); PG8_BAR;
            }
        }
        if constexpr (ALIGN_EPI) { if (wr == 0) PG8_BAR; }
        if constexpr (!Epi::AFTER_DRAIN) { E(acc, cur, wr, wc, fr, fq); S.done(cur); }
        if (!has_next) break;
#pragma unroll
        for (int a = 0; a < 2; ++a)
#pragma unroll
            for (int b = 0; b < 2; ++b)
#pragma unroll
                for (int m = 0; m < 4; ++m)
#pragma unroll
                    for (int n = 0; n < 2; ++n) acc[a][b][m][n] = (f32x4){0.f, 0.f, 0.f, 0.f};
        cur = nxt; cA = nA; cB = nB; ++ui;
        if constexpr (ALIGN_EPI) { if (wr == 1) PG8_BAR; }
    }
    PG8_WAIT_V(0);
    if constexpr (!ALIGN_EPI) { if (wr == 0) PG8_BAR; }
    PG8_BAR;
    if constexpr (Epi::AFTER_DRAIN) { E.fused(acc, cur, wr, wc, fr, fq, lds, wid, lane); S.done(cur); }
#undef PG8_SA
#undef PG8_SB
#undef PG8_STAGE
#undef PG8_LDA
#undef PG8_LDB
#undef PG8_MMA
#undef PG8_WAIT_V
#undef PG8_WAIT_L
#undef PG8_BAR
#undef PG8_SCHED
}
}

namespace pg8 {
template <bool ACCUM> struct EpiGateBf16 {
    static constexpr bool PERM = true, AFTER_DRAIN = false;
    bf16_t* O; const bf16_t* G; int ldc;
    __device__ __forceinline__ void operator()(const f32x4 (&acc)[2][2][4][2], const Unit& u, int wr, int wc, int fr, int fq) const {
        const int row0 = u.pm * BM + wr * 64 + fr, col0 = u.pn * BM + wc * 32 + 8 * fq;
#pragma unroll
        for (int ai = 0; ai < 2; ++ai)
#pragma unroll
            for (int m = 0; m < 4; ++m) { const size_t ro = (size_t)(row0 + ai * HALF + m * 16) * ldc + col0;
#pragma unroll
                for (int bj = 0; bj < 2; ++bj) { const u32x4 gv = *(const u32x4*)(G + ro + bj * HALF);
                    f32x4 v0 = acc[ai][bj][m][0], v1 = acc[ai][bj][m][1];
                    v0[0] *= __builtin_bit_cast(float, gv.x << 16); v0[1] *= __builtin_bit_cast(float, gv.x & 0xffff0000u); v0[2] *= __builtin_bit_cast(float, gv.y << 16); v0[3] *= __builtin_bit_cast(float, gv.y & 0xffff0000u);
                    v1[0] *= __builtin_bit_cast(float, gv.z << 16); v1[1] *= __builtin_bit_cast(float, gv.z & 0xffff0000u); v1[2] *= __builtin_bit_cast(float, gv.w << 16); v1[3] *= __builtin_bit_cast(float, gv.w & 0xffff0000u);
                    if (ACCUM) { const u32x4 ov = *(const u32x4*)(O + ro + bj * HALF);
                        v0[0] += __builtin_bit_cast(float, ov.x << 16); v0[1] += __builtin_bit_cast(float, ov.x & 0xffff0000u); v0[2] += __builtin_bit_cast(float, ov.y << 16); v0[3] += __builtin_bit_cast(float, ov.y & 0xffff0000u);
                        v1[0] += __builtin_bit_cast(float, ov.z << 16); v1[1] += __builtin_bit_cast(float, ov.z & 0xffff0000u); v1[2] += __builtin_bit_cast(float, ov.w << 16); v1[3] += __builtin_bit_cast(float, ov.w & 0xffff0000u); }
                    u32x4 w; w.x = cvt_pk_bf16(v0[0], v0[1]); w.y = cvt_pk_bf16(v0[2], v0[3]); w.z = cvt_pk_bf16(v1[0], v1[1]); w.w = cvt_pk_bf16(v1[2], v1[3]);
                    *(u32x4*)(O + ro + bj * HALF) = w; } }
    }
};
struct EpiResF32 {
    static constexpr bool PERM = false, AFTER_DRAIN = false;
    float* C; const float* X; int ldc; float scale;
    __device__ __forceinline__ void operator()(const f32x4 (&acc)[2][2][4][2], const Unit& u, int wr, int wc, int fr, int fq) const {
        const int row0 = u.pm * BM + wr * 64 + fr, col0 = u.pn * BM + wc * 32 + 4 * fq;
#pragma unroll
        for (int ai = 0; ai < 2; ++ai)
#pragma unroll
            for (int m = 0; m < 4; ++m) { const size_t ro = (size_t)(row0 + ai * HALF + m * 16) * ldc + col0;
#pragma unroll
                for (int bj = 0; bj < 2; ++bj)
#pragma unroll
                    for (int n = 0; n < 2; ++n) { const f32x4 xv = *(const f32x4*)(X + ro + bj * HALF + n * 16); *(f32x4*)(C + ro + bj * HALF + n * 16) = xv * scale + acc[ai][bj][m][n]; } }
    }
};
}

namespace pg8 {
template <class Epi, class Sched, int K>
__device__ __forceinline__ void gemm_phase_x(PG8_LAS unsigned char* lds, const char* Abase, const Sched& S, const Epi& E) {
    typedef typename Sched::UnitT UnitT;
    const int tid = threadIdx.x, wid = __builtin_amdgcn_readfirstlane(tid >> 6), lane = tid & 63, wr = wid >> 2, wc = wid & 3, fr = lane & 15, fq = lane >> 4;
    constexpr int nt = K / BK;
    int RA[2]; unsigned CA2[2], voffB[2];
#pragma unroll
    for (int i = 0; i < 2; ++i) { int R, C; stage_rc(tid * 16 + i * 8192, R, C); const int Rb = Epi::PERM ? ((R & ~31) + perm32(R & 31)) : R;
        RA[i] = R; CA2[i] = (unsigned)C * 2u; voffB[i] = (unsigned)(Rb * K + C) * 2u; }
    const size_t kstep = (size_t)(BK * 2);
    const size_t hstep = (size_t)HALF * K * 2;
    const unsigned ldsw = (unsigned)wid * 1024u;
    const int aoff = lds_byte(wr * 64 + fr, fq * 8), boff = lds_byte(wc * 32 + fr, fq * 8);
#define PG8_SA(b, h) (((b) * 2 + (h)) * HTB)
#define PG8_SB(b, h) ((4 + (b) * 2 + (h)) * HTB)
#define PG8_STAGE(bufoff, gbase, voff) do { _Pragma("unroll") for (int _i = 0; _i < 2; ++_i) \
        __builtin_amdgcn_global_load_lds((const unsigned*)((const char*)(gbase) + (voff)[_i]), (PG8_LAS unsigned*)(lds + (bufoff) + ldsw + _i * 8192), 16, 0, 0); } while (0)
#define PG8_LDA(dst, b, h) do { _Pragma("unroll") for (int m = 0; m < 4; ++m) _Pragma("unroll") for (int k = 0; k < 2; ++k) dst[m][k] = *(const PG8_LAS bf16x8*)(lds + PG8_SA(b, h) + aoff + m * 2048 + k * 1024); } while (0)
#define PG8_LDB(dst, b, h) do { _Pragma("unroll") for (int n = 0; n < 2; ++n) _Pragma("unroll") for (int k = 0; k < 2; ++k) dst[n][k] = *(const PG8_LAS bf16x8*)(lds + PG8_SB(b, h) + boff + n * 2048 + k * 1024); } while (0)
#define PG8_MMA(ai, bj, At, Bt) do { __builtin_amdgcn_s_setprio(1); _Pragma("unroll") for (int m = 0; m < 4; ++m) _Pragma("unroll") for (int n = 0; n < 2; ++n) _Pragma("unroll") for (int k = 0; k < 2; ++k) \
        acc[ai][bj][m][n] = __builtin_amdgcn_mfma_f32_16x16x32_bf16(Bt[n][k], At[m][k], acc[ai][bj][m][n], 0, 0, 0); __builtin_amdgcn_s_setprio(0); } while (0)
#define PG8_WAIT_V(n) asm volatile("s_waitcnt vmcnt(" #n ")" ::: "memory")
#define PG8_WAIT_L(n) asm volatile("s_waitcnt lgkmcnt(" #n ")" ::: "memory")
#define PG8_BAR __builtin_amdgcn_s_barrier()
#define PG8_SCHED __builtin_amdgcn_sched_barrier(0)
    UnitT cur, nxt; int ui = 0;
    if (!S.next(0, cur)) return;
    f32x4 acc[2][2][4][2];
#pragma unroll
    for (int a = 0; a < 2; ++a)
#pragma unroll
        for (int b = 0; b < 2; ++b)
#pragma unroll
            for (int m = 0; m < 4; ++m)
#pragma unroll
                for (int n = 0; n < 2; ++n) acc[a][b][m][n] = (f32x4){0.f, 0.f, 0.f, 0.f};
    bf16x8 At[4][2], B0[2][2], B1[2][2];
    unsigned vc0[2], vc1[2];
#pragma unroll
    for (int i = 0; i < 2; ++i) { vc0[i] = S.a_off(cur, RA[i]) + CA2[i]; vc1[i] = S.a_off(cur, HALF + RA[i]) + CA2[i]; }
    const char* cB = S.b_ptr(cur);
    PG8_STAGE(PG8_SB(0, 0), cB, voffB); PG8_STAGE(PG8_SB(0, 1), cB + hstep, voffB); PG8_STAGE(PG8_SA(0, 0), Abase + S.koff(0), vc0); PG8_STAGE(PG8_SA(0, 1), Abase + S.koff(0), vc1);
    if (wr == 1) PG8_BAR;
    PG8_WAIT_V(2); PG8_BAR;
    PG8_STAGE(PG8_SB(1, 0), cB + kstep, voffB); PG8_STAGE(PG8_SA(1, 0), Abase + S.koff(1), vc0); PG8_STAGE(PG8_SB(1, 1), cB + hstep + kstep, voffB);
    PG8_WAIT_V(6); PG8_BAR;
    for (;;) {
        const bool has_next = S.next(ui + 1, nxt);
        const char* nB = has_next ? S.b_ptr(nxt) : cB;
#pragma unroll 1
        for (int t = 0; t < nt; t += 2) {
            const bool last = (t == nt - 2);
            const char* a1 = Abase + S.koff(t + 1);
            const char* a2 = Abase + S.koff(last ? 0 : t + 2); const char* b2 = last ? nB : cB + (size_t)(t + 2) * kstep;
            const char* a3 = Abase + S.koff(last ? 1 : t + 3); const char* b3 = b2 + kstep;
            PG8_LDB(B0, 0, 0); PG8_LDB(B1, 0, 1); PG8_SCHED; PG8_LDA(At, 0, 0); PG8_STAGE(PG8_SA(1, 1), a1, vc1);
            if (last && has_next) {
#pragma unroll
                for (int i = 0; i < 2; ++i) { vc0[i] = S.a_off(nxt, RA[i]) + CA2[i]; vc1[i] = S.a_off(nxt, HALF + RA[i]) + CA2[i]; } }
            PG8_WAIT_V(8); PG8_WAIT_L(0); PG8_BAR; PG8_MMA(0, 0, At, B0); PG8_MMA(0, 1, At, B1); PG8_BAR; PG8_SCHED;
            PG8_LDA(At, 0, 1); PG8_STAGE(PG8_SB(0, 0), b2, voffB); PG8_STAGE(PG8_SB(0, 1), b2 + hstep, voffB); PG8_STAGE(PG8_SA(0, 0), a2, vc0);
            PG8_WAIT_V(8); PG8_WAIT_L(0); PG8_BAR; PG8_MMA(1, 0, At, B0); PG8_MMA(1, 1, At, B1); PG8_BAR; PG8_SCHED;
            PG8_LDB(B0, 1, 0); PG8_LDB(B1, 1, 1); PG8_SCHED; PG8_LDA(At, 1, 0); PG8_STAGE(PG8_SA(0, 1), a2, vc1);
            PG8_WAIT_V(8); PG8_WAIT_L(0); PG8_BAR; PG8_MMA(0, 0, At, B0); PG8_MMA(0, 1, At, B1); PG8_BAR; PG8_SCHED;
            PG8_LDA(At, 1, 1); PG8_STAGE(PG8_SB(1, 0), b3, voffB); PG8_STAGE(PG8_SB(1, 1), b3 + hstep, voffB); PG8_STAGE(PG8_SA(1, 0), a3, vc0);
            PG8_WAIT_V(8); PG8_WAIT_L(0); PG8_BAR; PG8_MMA(1, 0, At, B0); PG8_MMA(1, 1, At, B1); PG8_BAR; PG8_SCHED;
        }
        if (wr == 0) PG8_BAR;
        E(acc, cur, wr, wc, fr, fq);
        if (!has_next) break;
#pragma unroll
        for (int a = 0; a < 2; ++a)
#pragma unroll
            for (int b = 0; b < 2; ++b)
#pragma unroll
                for (int m = 0; m < 4; ++m)
#pragma unroll
                    for (int n = 0; n < 2; ++n) acc[a][b][m][n] = (f32x4){0.f, 0.f, 0.f, 0.f};
        cur = nxt; cB = nB; ++ui;
        if (wr == 1) PG8_BAR;
    }
    PG8_WAIT_V(0);
    PG8_BAR;
#undef PG8_SA
#undef PG8_SB
#undef PG8_STAGE
#undef PG8_LDA
#undef PG8_LDB
#undef PG8_MMA
#undef PG8_WAIT_V
#undef PG8_WAIT_L
#undef PG8_BAR
#undef PG8_SCHED
}

struct GUnit { int e, rt, pn, ce, slot0; };
struct GroupSched {
    typedef GUnit UnitT;
    const PG8_LAS int* U;
    const int* BIN;
    const char* W; size_t wse, wsp;
    unsigned rowbytes;
    static constexpr int MAXU = 64;
    __device__ __forceinline__ bool next(int i, GUnit& u) const {
        if (i >= MAXU) return false;
        const int e = __builtin_amdgcn_readfirstlane(U[i * 8 + 0]); if (e < 0) return false;
        u.e = e; u.rt = __builtin_amdgcn_readfirstlane(U[i * 8 + 1]); u.pn = __builtin_amdgcn_readfirstlane(U[i * 8 + 2]);
        u.ce = __builtin_amdgcn_readfirstlane(U[i * 8 + 3]); u.slot0 = __builtin_amdgcn_readfirstlane(U[i * 8 + 4]);
        return true;
    }
    __device__ __forceinline__ unsigned a_off(const GUnit& u, int R) const {
        int rr = u.rt * 256 + R; if (rr >= u.ce) rr = u.ce - 1;
        if (BIN) { const int tok = (u.e < 256) ? BIN[(size_t)u.e * 32768 + rr] : rr; return (unsigned)tok * rowbytes; }
        return (unsigned)(u.slot0 - u.rt * 256 + rr) * rowbytes;
    }
    __device__ __forceinline__ const char* b_ptr(const GUnit& u) const { return W + (size_t)u.e * wse + (size_t)u.pn * wsp; }
    __device__ __forceinline__ size_t koff(int kt) const { return (size_t)kt * 128; }
};
struct RUnit { int pm; };
struct RouterSched {
    typedef RUnit UnitT;
    int G, c; const char* W; size_t lo_off;
    __device__ __forceinline__ bool next(int i, RUnit& u) const { const int item = i * G + c; if (item >= 128) return false; u.pm = item; return true; }
    __device__ __forceinline__ unsigned a_off(const RUnit& u, int R) const { return (unsigned)(u.pm * 256 + R) * 2048u; }
    __device__ __forceinline__ const char* b_ptr(const RUnit&) const { return W; }
    __device__ __forceinline__ size_t koff(int kt) const { return (size_t)(kt & 15) * 128 + (((kt >> 4) == 1) ? lo_off : 0); }
};
struct EpiLogits {
    static constexpr bool PERM = false;
    float* C;
    __device__ __forceinline__ void operator()(const f32x4 (&acc)[2][2][4][2], const RUnit& u, int wr, int wc, int fr, int fq) const {
        const int row0 = u.pm * BM + wr * 64 + fr, col0 = wc * 32 + 4 * fq;
#pragma unroll
        for (int ai = 0; ai < 2; ++ai)
#pragma unroll
            for (int m = 0; m < 4; ++m) { float* rowp = C + (size_t)(row0 + ai * HALF + m * 16) * 256 + col0;
#pragma unroll
                for (int bj = 0; bj < 2; ++bj)
#pragma unroll
                    for (int n = 0; n < 2; ++n) *(f32x4*)(rowp + bj * HALF + n * 16) = acc[ai][bj][m][n]; }
    }
};
__device__ __forceinline__ float silu_f(float v) { return v * __builtin_amdgcn_rcpf(1.0f + __expf(-v)); }
struct EpiSwiglu {
    static constexpr bool PERM = true;
    bf16_t* HID;
    __device__ __forceinline__ void operator()(const f32x4 (&acc)[2][2][4][2], const GUnit& u, int wr, int wc, int fr, int fq) const {
        const int col0 = 128 * u.pn + wc * 32 + 8 * fq, rmax = u.ce - u.rt * 256;
#pragma unroll
        for (int ai = 0; ai < 2; ++ai)
#pragma unroll
            for (int m = 0; m < 4; ++m) { const int row = ai * HALF + wr * 64 + m * 16 + fr;
                if (row < rmax) { const f32x4 a0 = acc[ai][0][m][0], a1 = acc[ai][0][m][1], g0 = acc[ai][1][m][0], g1 = acc[ai][1][m][1];
                    u32x4 w; w.x = cvt_pk_bf16(silu_f(a0[0]) * g0[0], silu_f(a0[1]) * g0[1]); w.y = cvt_pk_bf16(silu_f(a0[2]) * g0[2], silu_f(a0[3]) * g0[3]);
                    w.z = cvt_pk_bf16(silu_f(a1[0]) * g1[0], silu_f(a1[1]) * g1[1]); w.w = cvt_pk_bf16(silu_f(a1[2]) * g1[2], silu_f(a1[3]) * g1[3]);
                    *(u32x4*)(HID + (size_t)(u.slot0 + row) * 256 + col0) = w; } }
    }
};
struct EpiRowsBf16 {
    static constexpr bool PERM = true;
    bf16_t* Y; int ldc;
    __device__ __forceinline__ void operator()(const f32x4 (&acc)[2][2][4][2], const GUnit& u, int wr, int wc, int fr, int fq) const {
        const int col0 = 256 * u.pn + wc * 32 + 8 * fq, rmax = u.ce - u.rt * 256;
#pragma unroll
        for (int ai = 0; ai < 2; ++ai)
#pragma unroll
            for (int m = 0; m < 4; ++m) { const int row = ai * HALF + wr * 64 + m * 16 + fr;
                if (row < rmax) {
#pragma unroll
                    for (int bj = 0; bj < 2; ++bj) { const f32x4 v0 = acc[ai][bj][m][0], v1 = acc[ai][bj][m][1];
                        u32x4 w; w.x = cvt_pk_bf16(v0[0], v0[1]); w.y = cvt_pk_bf16(v0[2], v0[3]); w.z = cvt_pk_bf16(v1[0], v1[1]); w.w = cvt_pk_bf16(v1[2], v1[3]);
                        *(u32x4*)(Y + (size_t)(u.slot0 + row) * ldc + col0 + bj * HALF) = w; } } }
    }
};
}

#include <hip/hip_bf16.h>
#include <cmath>
namespace attn_body {
using bf16=__hip_bfloat16;
using bf16x8=__attribute__((ext_vector_type(8)))short;
using s16x4=__attribute__((ext_vector_type(4)))short;
using f32x16=__attribute__((ext_vector_type(16)))float;
using u32x4=__attribute__((ext_vector_type(4)))unsigned;
using f32x4=__attribute__((ext_vector_type(4)))float;
constexpr int BATCH=16,NHEAD=8,SEQ=2048,D=64,DM=NHEAD*D;
constexpr int NW=8,QBLK=32,QB=QBLK*NW,KVBLK=64,NQB=SEQ/QB;
constexpr int ATTN_PITCH=DM, ATTN_UNIT_ROWS=QB;
__device__ __forceinline__ int crow(int r,int hi){return (r&3)+8*(r>>2)+4*hi;}
#define SBAR() __builtin_amdgcn_sched_barrier(0)
__device__ __forceinline__ void cmask(f32x16&p0,f32x16&p1,int jb,int qrel,int hi){
  const float NEG=-INFINITY; int kb=64*jb+4*hi;
  #pragma unroll
  for(int r=0;r<16;++r){int kv=kb+(r&3)+8*(r>>2); if(kv>qrel)p0[r]=NEG; if(kv+32>qrel)p1[r]=NEG;}
}

constexpr int NSLOT=3, SLOTB=8192;
constexpr int LDS_K=0, LDS_V=NSLOT*SLOTB, LDS_WS=2*NSLOT*SLOTB, LDS_OST=LDS_WS+NW*64*4, LDS_BYTES=LDS_OST+NW*4096;
constexpr float C2=0.125f*1.4426950408889634f;
__device__ __forceinline__ void glds16(const void*gsrc,unsigned lds_dst){unsigned keep;
  asm volatile("s_mov_b32 %0, m0\n\ts_mov_b32 m0, %2\n\ts_nop 0\n\tglobal_load_lds_dwordx4 %1, off\n\ts_mov_b32 m0, %0":"=&s"(keep):"v"(gsrc),"s"(lds_dst):"memory");}
__device__ __forceinline__ float max3f(float a,float b,float c){float r;asm("v_max3_f32 %0, %1, %2, %3":"=v"(r):"v"(a),"v"(b),"v"(c));return r;}
__device__ __forceinline__ float max2f(float a,float b){float r;asm("v_max_f32_e32 %0, %1, %2":"=v"(r):"v"(a),"v"(b));return r;}
__device__ __forceinline__ float fadd_s(float a,float b){float r;asm("v_add_f32_e32 %0, %1, %2":"=v"(r):"v"(a),"v"(b));return r;}
__device__ __forceinline__ float fsub_s(float a,float b){float r;asm("v_sub_f32_e32 %0, %1, %2":"=v"(r):"v"(a),"v"(b));return r;}
typedef float f32x2_t __attribute__((ext_vector_type(2))); typedef __bf16 bf16x2_t __attribute__((ext_vector_type(2)));
__device__ __forceinline__ unsigned cvtpk_s(float lo,float hi){f32x2_t v={lo,hi};bf16x2_t b=__builtin_convertvector(v,bf16x2_t);return __builtin_bit_cast(unsigned,b);}
#define WAIT_BAR(N) asm volatile("s_waitcnt vmcnt(" #N ") lgkmcnt(0)\n\ts_barrier":::"memory")

__device__ __forceinline__ void qkt(f32x16&p0,f32x16&p1,const char*Kslot,const bf16x8*qr,const f32x16&negm,int r32,int hi){
  const char*kb=Kslot+hi*1024+r32*16;
  #pragma unroll
  for(int d0=0;d0<4;++d0){
    const bf16x8 b0=*reinterpret_cast<const bf16x8*>(kb+d0*2048);
    const bf16x8 b1=*reinterpret_cast<const bf16x8*>(kb+d0*2048+512);
    if(d0==0){p0=__builtin_amdgcn_mfma_f32_32x32x16_bf16(b0,qr[0],negm,0,0,0);p1=__builtin_amdgcn_mfma_f32_32x32x16_bf16(b1,qr[0],negm,0,0,0);}
    else{p0=__builtin_amdgcn_mfma_f32_32x32x16_bf16(b0,qr[d0],p0,0,0,0);p1=__builtin_amdgcn_mfma_f32_32x32x16_bf16(b1,qr[d0],p1,0,0,0);}}
}
typedef __attribute__((address_space(3))) const char* lds_cptr;
typedef short v4i16_t __attribute__((ext_vector_type(4)));
__device__ __forceinline__ void kload8(bf16x8*kf,lds_cptr kp){
  kf[0]=*(const __attribute__((address_space(3))) bf16x8*)(kp);      kf[1]=*(const __attribute__((address_space(3))) bf16x8*)(kp+512);
  kf[2]=*(const __attribute__((address_space(3))) bf16x8*)(kp+2048); kf[3]=*(const __attribute__((address_space(3))) bf16x8*)(kp+2560);
  kf[4]=*(const __attribute__((address_space(3))) bf16x8*)(kp+4096); kf[5]=*(const __attribute__((address_space(3))) bf16x8*)(kp+4608);
  kf[6]=*(const __attribute__((address_space(3))) bf16x8*)(kp+6144); kf[7]=*(const __attribute__((address_space(3))) bf16x8*)(kp+6656);
}
__device__ __forceinline__ void kload2(bf16x8*kf,lds_cptr kp,int j){ kf[2*j]=*(const __attribute__((address_space(3))) bf16x8*)(kp+j*2048); kf[2*j+1]=*(const __attribute__((address_space(3))) bf16x8*)(kp+j*2048+512); }
__device__ __forceinline__ s16x4 vtr(lds_cptr p){ return __builtin_bit_cast(s16x4,__builtin_amdgcn_ds_read_tr16_b64_v4i16((__attribute__((address_space(3))) v4i16_t*)p)); }
__device__ __forceinline__ float rowmax(const f32x16&p0,const f32x16&p1){
  float a=max3f(p0[0],p0[1],p1[0]),b=max3f(p0[2],p0[3],p1[1]);a=max3f(a,p1[2],p1[3]);
  #pragma unroll
  for(int r=4;r<16;r+=4){a=max3f(a,p0[r],p0[r+1]);b=max3f(b,p0[r+2],p0[r+3]);a=max3f(a,p1[r],p1[r+1]);b=max3f(b,p1[r+2],p1[r+3]);}
  const float m=max2f(a,b);
  auto rr=__builtin_amdgcn_permlane32_swap(__float_as_uint(m),__float_as_uint(m),false,false);
  return max2f(__uint_as_float(rr[0]),__uint_as_float(rr[1]));
}
__device__ __forceinline__ void pv(f32x16*o,int vb,bf16x8 pa0,bf16x8 pa1,bf16x8 pa2,bf16x8 pa3){
  #pragma unroll
  for(int d0=0;d0<2;++d0){s16x4 lo[4],hi[4];
    #pragma unroll
    for(int ks=0;ks<4;++ks){
      asm volatile("ds_read_b64_tr_b16 %0,%1 offset:%c2":"=&v"(lo[ks]):"v"(vb),"i"(d0*4096+ks*1024):"memory");
      asm volatile("ds_read_b64_tr_b16 %0,%1 offset:%c2":"=&v"(hi[ks]):"v"(vb),"i"(d0*4096+ks*1024+512):"memory");}
    asm volatile("s_waitcnt lgkmcnt(0)":::"memory");SBAR();
    #define PK(k) (bf16x8){lo[k][0],lo[k][1],lo[k][2],lo[k][3],hi[k][0],hi[k][1],hi[k][2],hi[k][3]}
    o[d0]=__builtin_amdgcn_mfma_f32_32x32x16_bf16(pa0,PK(0),o[d0],0,0,0);
    o[d0]=__builtin_amdgcn_mfma_f32_32x32x16_bf16(pa1,PK(1),o[d0],0,0,0);
    o[d0]=__builtin_amdgcn_mfma_f32_32x32x16_bf16(pa2,PK(2),o[d0],0,0,0);
    o[d0]=__builtin_amdgcn_mfma_f32_32x32x16_bf16(pa3,PK(3),o[d0],0,0,0);
    #undef PK
  }
}

#ifndef ATTN_STORE16
#define ATTN_STORE16(p,v) (*(u32x4*)(p)=(v))
#endif
template<int THRL> __device__ __forceinline__ void attn_unit(int b,int h,int qb,const bf16*Q,const bf16*__restrict__ K,const bf16*__restrict__ V,bf16*O,const float*KM,char*shm){
  const int tid=threadIdx.x,lane=tid&63,r32=lane&31,hi=lane>>5; const int wid=__builtin_amdgcn_readfirstlane(tid>>6);
  const long rowbase=(long)b*SEQ; const int q0=qb*QB;
  const bf16*Qw=Q+(rowbase+q0+wid*QBLK)*DM+h*D;
  const bf16*Kh=K+rowbase*DM+h*D,*Vh=V+rowbase*DM+h*D;
  const unsigned lds0=(unsigned)(uintptr_t)shm;
  float*wsf=(float*)(shm+LDS_WS)+wid*64;
  const bf16*ksrc=Kh+(long)lane*DM+wid*8;
  const bf16*vsrc=Vh+(long)(16*(wid&3)+(lane>>2))*DM+(wid>>2)*32+(lane&3)*8;
  const unsigned kdst=lds0+LDS_K+wid*1024, vdst=lds0+LDS_V+wid*1024;
  #define DMA_K(t,slot) glds16(ksrc+(long)(t)*KVBLK*DM,(unsigned)__builtin_amdgcn_readfirstlane(kdst+(slot)))
  #define DMA_V(t,slot) glds16(vsrc+(long)(t)*KVBLK*DM,(unsigned)__builtin_amdgcn_readfirstlane(vdst+(slot)))
  const int vb0=(int)(lds0+LDS_V)+((lane>>4)&1)*32+(lane&3)*8+(4*hi+((lane&15)>>2))*64;
  const char*Kbase=shm+LDS_K; bf16x8 kf[8];
  const lds_cptr shm3=(lds_cptr)shm; const lds_cptr kp0=shm3+LDS_K+hi*1024+r32*16; const lds_cptr vp0=shm3+LDS_V+((lane>>4)&1)*32+(lane&3)*8+(4*hi+((lane&15)>>2))*64;
  const int NT=(q0+QB)/KVBLK;
  DMA_K(0,0);DMA_V(0,0);DMA_K(1,SLOTB);
  bf16x8 qr[4];
  #pragma unroll
  for(int d0=0;d0<4;++d0)qr[d0]=*reinterpret_cast<const bf16x8*>(&Qw[(long)r32*DM+d0*16+hi*8]);
  unsigned sel=0xffu; const bool mmask=(qb>3);
  if(mmask){ float v0=-INFINITY,v1=-INFINITY,v2=-INFINITY; int i0=0,i1=0,i2=0;
    for(int j=0;j<qb;++j){ const float*km=KM+j*64+hi*8; float a=0.f;
      #pragma unroll
      for(int d0=0;d0<4;++d0){ const f32x4 ka=*reinterpret_cast<const f32x4*>(km+d0*16), kb=*reinterpret_cast<const f32x4*>(km+d0*16+4);
        a+=__builtin_bit_cast(float,(unsigned)(unsigned short)qr[d0][0]<<16)*ka[0]+__builtin_bit_cast(float,(unsigned)(unsigned short)qr[d0][1]<<16)*ka[1]+__builtin_bit_cast(float,(unsigned)(unsigned short)qr[d0][2]<<16)*ka[2]+__builtin_bit_cast(float,(unsigned)(unsigned short)qr[d0][3]<<16)*ka[3];
        a+=__builtin_bit_cast(float,(unsigned)(unsigned short)qr[d0][4]<<16)*kb[0]+__builtin_bit_cast(float,(unsigned)(unsigned short)qr[d0][5]<<16)*kb[1]+__builtin_bit_cast(float,(unsigned)(unsigned short)qr[d0][6]<<16)*kb[2]+__builtin_bit_cast(float,(unsigned)(unsigned short)qr[d0][7]<<16)*kb[3]; }
      a+=__shfl_xor(a,32);
      if(a>v0){v2=v1;i2=i1;v1=v0;i1=i0;v0=a;i0=j;} else if(a>v1){v2=v1;i2=i1;v1=a;i1=j;} else if(a>v2){v2=a;i2=j;} }
    sel=(1u<<i0)|(1u<<i1)|(1u<<i2); }
  #define MOBA(P0,P1,t) do{ if(mmask){ const bool keep_=(sel>>((t)>>2))&1u; _Pragma("unroll") for(int r=0;r<16;++r){P0[r]=keep_?P0[r]:-INFINITY;P1[r]=keep_?P1[r]:-INFINITY;} } }while(0)
  float mhat=0.f,l_reg=0.f;f32x16 o[2];o[0]=f32x16{};o[1]=f32x16{};f32x16 negm=f32x16{};asm volatile("":"+v"(negm));
  const int qrel=wid*QBLK+r32;
  #define CMASK(P0,P1,t) do{int jb_=(t)-(NT-4); if(jb_>=0)cmask(P0,P1,jb_,qrel,hi); else MOBA(P0,P1,t);}while(0)
  bool resc=false;
  #define START(P0,P1) do{ const float rm=rowmax(P0,P1); resc=false; \
    { const float dl=__builtin_fmaxf(rm,-128.f); mhat=fadd_s(mhat,dl); \
      _Pragma("unroll") for(int r=0;r<16;++r){P0[r]=fsub_s(P0[r],dl);P1[r]=fsub_s(P1[r],dl);} \
      _Pragma("unroll") for(int r=0;r<16;++r)negm[r]=-mhat; asm volatile("":"+v"(negm)); } \
    _Pragma("unroll") for(int r=0;r<16;++r)P0[r]=__builtin_amdgcn_exp2f(P0[r]); }while(0)
  #define RESC() do{ if(resc){ asm volatile("s_waitcnt lgkmcnt(0)":::"memory"); \
      _Pragma("unroll") for(int d_=0;d_<2;++d_) _Pragma("unroll") for(int r=0;r<16;++r)o[d_][r]*=wsf[crow(r,hi)]; } }while(0)
  f32x16 pA0,pA1,pB0,pB1;
  int sl_prev=0,sl_cur=0,sl_next=SLOTB;
  #define ROT() do{sl_prev=sl_cur;sl_cur=sl_next;sl_next=(sl_next==(NSLOT-1)*SLOTB)?0:sl_next+SLOTB;}while(0)
  DMA_K(2,2*SLOTB);
  WAIT_BAR(3);
  qkt(pA0,pA1,Kbase,qr,negm,r32,hi);asm volatile("s_nop 15\n\ts_nop 7":"+v"(pA0),"+v"(pA1));CMASK(pA0,pA1,0);
  START(pA0,pA1);
  _Pragma("unroll") for(int r=0;r<16;++r)pA1[r]=__builtin_amdgcn_exp2f(pA1[r]);
  WAIT_BAR(0);
  DMA_K(3,0);DMA_V(1,SLOTB);
  ROT();
  kload8(kf,kp0+sl_cur);
  WAIT_BAR(2);
  s16x4 vlo[8],vhi[8]; u32x4 pw0,pw1,pw2,pw3;
  #define PKW(P,B) cvtpk_s(P[B],P[B+1])
  #define PAF(k) __builtin_bit_cast(bf16x8,pw##k)
  #define VFR(i) (bf16x8){vlo[i][0],vlo[i][1],vlo[i][2],vlo[i][3],vhi[i][0],vhi[i][1],vhi[i][2],vhi[i][3]}
  #define PIN(x) asm volatile("":"+v"(x))
  #define MX3(a,b,c) __builtin_fmaxf(__builtin_fmaxf((a),(b)),(c))
  #define GAPA(MF,A0,A1,A2,A3,W0,W1,PW) do{ MF; sacc+=A0; sacc+=A1; sacc+=A2; sacc+=A3; PIN(sacc); W0; W1; PIN(PW); SBAR(); }while(0)
  #define EX(v) __builtin_amdgcn_exp2f(v)
  #define GAPB(MF,X,B) do{ MF; X[B]=EX(X[B]); X[B+1]=EX(X[B+1]); X[B+2]=EX(X[B+2]); X[B+3]=EX(X[B+3]); PIN(X); SBAR(); }while(0)
  #define VRD(i) do{ vlo[i]=vtr(vp_+(((i)>>2)*4096+((i)&3)*1024)); vhi[i]=vtr(vp_+(((i)>>2)*4096+((i)&3)*1024+512)); }while(0)
  #define KRD(G,j) do{ if(G){ kload2(kf,kp0+sl_next,j); SBAR(); } }while(0)
  #define STEP(C0,C1,P0,P1,t,GK,GV,GL) do{ SBAR(); \
    const lds_cptr vp_=vp0+sl_prev; \
    VRD(0); SBAR(); float sacc=(P0[0]+P0[1]); \
    GAPA(C0=__builtin_amdgcn_mfma_f32_32x32x16_bf16(kf[0],qr[0],negm,0,0,0), P0[2],P0[3],P0[4],P0[5],     pw0[0]=PKW(P0,0), pw0[1]=PKW(P0,2), pw0); \
    VRD(4); SBAR(); GAPA(C1=__builtin_amdgcn_mfma_f32_32x32x16_bf16(kf[1],qr[0],negm,0,0,0), P0[6],P0[7],P0[8],P0[9],     pw0[2]=PKW(P0,4), pw0[3]=PKW(P0,6), pw0); \
    VRD(1); SBAR(); GAPA(C0=__builtin_amdgcn_mfma_f32_32x32x16_bf16(kf[2],qr[1],C0,0,0,0),   P0[10],P0[11],P0[12],P0[13], pw1[0]=PKW(P0,8), pw1[1]=PKW(P0,10), pw1); \
    VRD(5); SBAR(); GAPA(C1=__builtin_amdgcn_mfma_f32_32x32x16_bf16(kf[3],qr[1],C1,0,0,0),   P0[14],P0[15],P1[0],P1[1],   pw1[2]=PKW(P0,12),pw1[3]=PKW(P0,14), pw1); \
    VRD(2); SBAR(); GAPA(C0=__builtin_amdgcn_mfma_f32_32x32x16_bf16(kf[4],qr[2],C0,0,0,0),   P1[2],P1[3],P1[4],P1[5],     pw2[0]=PKW(P1,0), pw2[1]=PKW(P1,2), pw2); \
    VRD(6); SBAR(); GAPA(C1=__builtin_amdgcn_mfma_f32_32x32x16_bf16(kf[5],qr[2],C1,0,0,0),   P1[6],P1[7],P1[8],P1[9],     pw2[2]=PKW(P1,4), pw2[3]=PKW(P1,6), pw2); \
    VRD(3); SBAR(); GAPA(C0=__builtin_amdgcn_mfma_f32_32x32x16_bf16(kf[6],qr[3],C0,0,0,0),   P1[10],P1[11],P1[12],P1[13], pw3[0]=PKW(P1,8), pw3[1]=PKW(P1,10), pw3); \
    VRD(7); SBAR(); GAPA(C1=__builtin_amdgcn_mfma_f32_32x32x16_bf16(kf[7],qr[3],C1,0,0,0),   P1[14],P1[15],0.f,0.f,       pw3[2]=PKW(P1,12),pw3[3]=PKW(P1,14), pw3); \
    l_reg+=sacc; \
    if(GK){DMA_K((t)+3,sl_cur);} if(GV){DMA_V((t)+1,sl_next);} \
    CMASK(C0,C1,t); \
    { float a=MX3(C0[0],C0[1],C1[0]),b=MX3(C0[2],C0[3],C1[1]); a=MX3(a,C1[2],C1[3]); \
      _Pragma("unroll") for(int r=4;r<16;r+=4){a=MX3(a,C0[r],C0[r+1]);b=MX3(b,C0[r+2],C0[r+3]);a=MX3(a,C1[r],C1[r+1]);b=MX3(b,C1[r+2],C1[r+3]);} \
      float rm=__builtin_fmaxf(a,b); { auto rr=__builtin_amdgcn_permlane32_swap(__float_as_uint(rm),__float_as_uint(rm),false,false); rm=__builtin_fmaxf(__uint_as_float(rr[0]),__uint_as_float(rr[1])); } \
      resc=false; \
      if(__builtin_expect(__any(rm>(float)THRL),0)){ const float dl=__builtin_fmaxf(rm,0.f); mhat+=dl; \
        _Pragma("unroll") for(int r=0;r<16;++r){C0[r]-=dl;C1[r]-=dl;} \
        _Pragma("unroll") for(int r=0;r<16;++r)negm[r]=-mhat; asm volatile("":"+v"(negm)); \
        const float f=__builtin_amdgcn_exp2f(-dl); l_reg*=f; if(hi==0)wsf[r32]=f; resc=true; } } \
    SBAR(); \
    GAPB(o[0]=__builtin_amdgcn_mfma_f32_32x32x16_bf16(PAF(0),VFR(0),o[0],0,0,0), C0,0); \
    GAPB(o[1]=__builtin_amdgcn_mfma_f32_32x32x16_bf16(PAF(0),VFR(4),o[1],0,0,0), C0,4); \
    KRD(GL,0); GAPB(o[0]=__builtin_amdgcn_mfma_f32_32x32x16_bf16(PAF(1),VFR(1),o[0],0,0,0), C0,8); \
    KRD(GL,1); GAPB(o[1]=__builtin_amdgcn_mfma_f32_32x32x16_bf16(PAF(1),VFR(5),o[1],0,0,0), C0,12); \
    KRD(GL,2); GAPB(o[0]=__builtin_amdgcn_mfma_f32_32x32x16_bf16(PAF(2),VFR(2),o[0],0,0,0), C1,0); \
    KRD(GL,3); GAPB(o[1]=__builtin_amdgcn_mfma_f32_32x32x16_bf16(PAF(2),VFR(6),o[1],0,0,0), C1,4); \
    GAPB(o[0]=__builtin_amdgcn_mfma_f32_32x32x16_bf16(PAF(3),VFR(3),o[0],0,0,0), C1,8); \
    GAPB(o[1]=__builtin_amdgcn_mfma_f32_32x32x16_bf16(PAF(3),VFR(7),o[1],0,0,0), C1,12); \
    }while(0)
  int t=1;
  #undef CMASK
  #define CMASK(P0,P1,t) MOBA(P0,P1,t)
  for(;t+5<NT;t+=2){
    STEP(pB0,pB1,pA0,pA1,t,true,true,true);     WAIT_BAR(2); RESC(); ROT();
    STEP(pA0,pA1,pB0,pB1,t+1,true,true,true);   WAIT_BAR(2); RESC(); ROT();
  }
  #undef CMASK
  #define CMASK(P0,P1,t) do{int jb_=(t)-(NT-4); if(jb_>=0)cmask(P0,P1,jb_,qrel,hi); else MOBA(P0,P1,t);}while(0)
  #define ENDW(tt) do{ if((tt)+3<NT){WAIT_BAR(2);} else if((tt)+2<NT){WAIT_BAR(1);} else {WAIT_BAR(0);} }while(0)
  for(;t+1<NT;t+=2){
    STEP(pB0,pB1,pA0,pA1,t,(t+3<NT),(t+1<NT),(t+1<NT));       ENDW(t);   RESC(); ROT();
    STEP(pA0,pA1,pB0,pB1,t+1,(t+4<NT),(t+2<NT),(t+2<NT));     ENDW(t+1); RESC(); ROT();
  }
  STEP(pB0,pB1,pA0,pA1,NT-1,false,false,false); RESC();
  { float sacc=pB0[0]+pB0[1]; _Pragma("unroll") for(int r=2;r<16;++r)sacc+=pB0[r]; _Pragma("unroll") for(int r=0;r<16;++r)sacc+=pB1[r]; l_reg+=sacc;
    pw0=(u32x4){PKW(pB0,0),PKW(pB0,2),PKW(pB0,4),PKW(pB0,6)};pw1=(u32x4){PKW(pB0,8),PKW(pB0,10),PKW(pB0,12),PKW(pB0,14)};pw2=(u32x4){PKW(pB1,0),PKW(pB1,2),PKW(pB1,4),PKW(pB1,6)};pw3=(u32x4){PKW(pB1,8),PKW(pB1,10),PKW(pB1,12),PKW(pB1,14)};
    SBAR(); pv(o,vb0+sl_cur,PAF(0),PAF(1),PAF(2),PAF(3)); }
  #undef PKW
  #undef PAF
  #undef VFR
  #undef PIN
  #undef MX3
  #undef GAPA
  #undef GAPB
  #undef EX
  #undef VRD
  #undef KRD
  #undef STEP
  #undef ENDW
  {auto rr=__builtin_amdgcn_permlane32_swap(__float_as_uint(l_reg),__float_as_uint(l_reg),false,false);l_reg=__uint_as_float(rr[0])+__uint_as_float(rr[1]);}
  if(hi==0)wsf[32+r32]=l_reg;asm volatile("s_waitcnt lgkmcnt(0)":::"memory");
  float rli[16];
  #pragma unroll
  for(int r=0;r<16;++r)rli[r]=__builtin_amdgcn_rcpf(wsf[32+crow(r,hi)]);
  bf16*Ow=O+(rowbase+q0+wid*QBLK)*DM+h*D;
  { bf16*stg=(bf16*)(shm+LDS_OST)+wid*2048;
    #pragma unroll
    for(int r=0;r<16;++r){const int orow=crow(r,hi);
      #pragma unroll
      for(int d0=0;d0<2;++d0)stg[orow*64+d0*32+r32]=__float2bfloat16(o[d0][r]*rli[r]);}
    asm volatile("s_waitcnt lgkmcnt(0)":::"memory");
    #pragma unroll
    for(int i=0;i<4;++i){const int row=i*8+(lane>>3),ch=lane&7; const u32x4 v=*(const u32x4*)(stg+row*64+ch*8); ATTN_STORE16(Ow+(long)row*DM+ch*8,v);} }
  asm volatile("s_waitcnt lgkmcnt(0)\n\ts_barrier":::"memory");
  #undef DMA_K
  #undef DMA_V
  #undef MOBA
  #undef CMASK
  #undef START
  #undef RESC
  #undef ROT
}
constexpr int ATTN_LDS_BYTES=LDS_BYTES;
struct AttnTensors { const bf16* Q; const bf16* K; const bf16* V; bf16* O; const float* KM; };
struct AttnUnit { int bh; int qb; };
struct MobaOrder {
  int vcu, G;
  __device__ __forceinline__ MobaOrder(int grid,int vcu_):vcu(vcu_),G(grid){}
  __device__ __forceinline__ bool next(int i,AttnUnit&u)const{
    if(G==256){ if(i>=4)return false; u.bh=vcu>>1; const int odd=vcu&1; u.qb=(i==0)?(7-odd):(i==1)?odd:(i==2)?(5-odd):(2+odd); return true; }
    const int x=i*G+vcu; if(x>=BATCH*NHEAD*NQB)return false; u.bh=x>>3; u.qb=x&7; return true; }
};
template<class Sched,int THRL=8> __device__ __forceinline__ void attn_phase(char*lds,const AttnTensors&T,const Sched&S){
  AttnUnit u;
  for(int i=0;S.next(i,u);++i){ attn_unit<THRL>(u.bh/NHEAD,u.bh%NHEAD,u.qb,T.Q,T.K,T.V,T.O,T.KM+(long)u.bh*(8*64),lds); }
}
#undef SBAR
#undef WAIT_BAR
}

namespace pg8 {
__device__ __forceinline__ float sigm_f(float v) { return __builtin_amdgcn_rcpf(1.0f + __expf(-v)); }
template <int N> __device__ __forceinline__ f32x4 row_ror4(const f32x4 v) {
    const int lane = threadIdx.x & 63, src = (lane & 48) | ((lane - N) & 15);
    f32x4 r;
#pragma unroll
    for (int j = 0; j < 4; ++j) r[j] = __shfl(v[j], src);
    return r;
}
struct EpiProj {
    static constexpr bool PERM = false, AFTER_DRAIN = false;
    unsigned char* ws; PG8_LAS unsigned char* xl;
    __device__ __forceinline__ void operator()(f32x4 (&acc)[2][2][4][2], const Unit& u, int wr, int wc, int fr, int fq) const {
        bf16_t* const AC = (bf16_t*)(ws + WS_AC); bf16_t* const GC = (bf16_t*)(ws + WS_GC); bf16_t* const GA = (bf16_t*)(ws + WS_GA);
        bf16_t* const Q = (bf16_t*)(ws + WS_Q); bf16_t* const K = (bf16_t*)(ws + WS_K); bf16_t* const V = (bf16_t*)(ws + WS_V);
        float* const KM = (float*)(ws + WS_KMEAN); float* const UH = (float*)(ws + WS_UH); float* const CBH = (float*)(ws + WS_CBH);
        const float* const rope = (const float*)(ws + WS_ROPE); const float* const bgate = IN_PTR(2); const float* const wconv = IN_PTR(3);
        const int row0 = u.pm * BM + wr * 64 + fr;
        if (u.pn < 16) {
            const int ch0 = 64 * u.pn + 16 * wc + 4 * fq;
#pragma unroll
            for (int ai = 0; ai < 2; ++ai)
#pragma unroll
                for (int m = 0; m < 4; ++m) acc[ai][0][m][1] = acc[ai][0][m][1] * acc[ai][1][m][0];
            PG8_LAS f32x4* X = (PG8_LAS f32x4*)xl;
            if (fr >= 14) {
#pragma unroll
                for (int ai = 0; ai < 2; ++ai) X[(((ai * 2 + wr) * 4 + wc) * 2 + (fr - 14)) * 4 + fq] = acc[ai][0][3][1]; }
            if (wr == 1 && fr >= 14) *(f32x4*)(UH + ((size_t)u.pm * 2 + (fr - 14)) * 1024 + ch0) = acc[1][0][3][1];
            if (wr == 0 && fr < 2) *(f32x4*)(CBH + ((size_t)u.pm * 2 + fr) * 1024 + ch0) = acc[0][0][0][0];
            const f32x4 bg = *(const f32x4*)(bgate + ch0), w0 = *(const f32x4*)(wconv + ch0), w1 = *(const f32x4*)(wconv + 1024 + ch0), w2 = *(const f32x4*)(wconv + 2048 + ch0);
            asm volatile("s_waitcnt lgkmcnt(0)" ::: "memory"); __builtin_amdgcn_s_barrier(); asm volatile("" ::: "memory");
#pragma unroll
            for (int ai = 0; ai < 2; ++ai) {
                f32x4 xm1, xm2;
                if (wr == 1) { xm2 = X[(((ai * 2 + 0) * 4 + wc) * 2 + 0) * 4 + fq]; xm1 = X[(((ai * 2 + 0) * 4 + wc) * 2 + 1) * 4 + fq]; }
                else if (ai == 1) { xm2 = X[(((0 * 2 + 1) * 4 + wc) * 2 + 0) * 4 + fq]; xm1 = X[(((0 * 2 + 1) * 4 + wc) * 2 + 1) * 4 + fq]; }
                else { xm2 = (f32x4){0.f, 0.f, 0.f, 0.f}; xm1 = xm2; }
                f32x4 r1p = xm1, r2p = xm2, r2q = xm1;
#pragma unroll
                for (int m = 0; m < 4; ++m) {
                    const f32x4 uu = acc[ai][0][m][1], r1 = row_ror4<1>(uu), r2 = row_ror4<2>(uu);
                    const f32x4 p1 = (fr == 0) ? r1p : r1, p2 = (fr == 0) ? r2p : (fr == 1) ? r2q : r2;
                    const f32x4 y = acc[ai][0][m][0] * (w0 * p2 + w1 * p1 + w2 * uu);
                    const f32x4 g = acc[ai][1][m][1] + bg;
                    const size_t ro = (size_t)(row0 + ai * HALF + m * 16) * 1024 + ch0;
                    u32x2v wa; wa.x = cvt_pk_bf16(y[0], y[1]); wa.y = cvt_pk_bf16(y[2], y[3]); *(u32x2v*)(AC + ro) = wa;
                    u32x2v wg; wg.x = cvt_pk_bf16(sigm_f(g[0]), sigm_f(g[1])); wg.y = cvt_pk_bf16(sigm_f(g[2]), sigm_f(g[3])); *(u32x2v*)(GC + ro) = wg;
                    r1p = r1; r2p = r2; r2q = r2;
                }
            }
            asm volatile("s_waitcnt lgkmcnt(0)" ::: "memory"); __builtin_amdgcn_s_barrier(); asm volatile("" ::: "memory");
        } else if (u.pn < 22) {
            const int which = (u.pn - 16) >> 1, half = (u.pn - 16) & 1;
            bf16_t* dst = (which == 0) ? Q : (which == 1) ? K : V;
            const int dbase = 32 * (wc & 1) + 16 * (fq >> 1) + 4 * (fq & 1);
            const bool rot = (which < 2) && ((wc & 1) == 0) && (fq < 2);
            const float sc = (which == 0) ? 0.18033688011112042f : 1.0f;
            f32x4 ks[2][2];
#pragma unroll
            for (int bj = 0; bj < 2; ++bj) { ks[bj][0] = (f32x4){0.f, 0.f, 0.f, 0.f}; ks[bj][1] = ks[bj][0]; }
#pragma unroll
            for (int ai = 0; ai < 2; ++ai)
#pragma unroll
                for (int m = 0; m < 4; ++m) { const int row = row0 + ai * HALF + m * 16; const int spos = row & 2047;
                    f32x4 cs = (f32x4){1.f, 1.f, 1.f, 1.f}, sn = (f32x4){0.f, 0.f, 0.f, 0.f};
                    if (rot) { cs = *(const f32x4*)(rope + spos * 8 + 4 * fq); sn = *(const f32x4*)(rope + 2048 * 8 + spos * 8 + 4 * fq); }
#pragma unroll
                    for (int bj = 0; bj < 2; ++bj) { const f32x4 a0 = acc[ai][bj][m][0], a1 = acc[ai][bj][m][1];
                        const f32x4 o0 = (a0 * cs - a1 * sn) * sc, o1 = (a1 * cs + a0 * sn) * sc;
                        u32x2v w0, w1; w0.x = cvt_pk_bf16(o0[0], o0[1]); w0.y = cvt_pk_bf16(o0[2], o0[3]); w1.x = cvt_pk_bf16(o1[0], o1[1]); w1.y = cvt_pk_bf16(o1[2], o1[3]);
                        bf16_t* rp = dst + (size_t)row * 512 + 64 * (4 * half + 2 * bj + (wc >> 1)) + dbase;
                        *(u32x2v*)rp = w0; *(u32x2v*)(rp + 8) = w1;
                        if (which == 1) { ks[bj][0][0] += __builtin_bit_cast(float, w0.x << 16); ks[bj][0][1] += __builtin_bit_cast(float, w0.x & 0xffff0000u); ks[bj][0][2] += __builtin_bit_cast(float, w0.y << 16); ks[bj][0][3] += __builtin_bit_cast(float, w0.y & 0xffff0000u);
                                          ks[bj][1][0] += __builtin_bit_cast(float, w1.x << 16); ks[bj][1][1] += __builtin_bit_cast(float, w1.x & 0xffff0000u); ks[bj][1][2] += __builtin_bit_cast(float, w1.y << 16); ks[bj][1][3] += __builtin_bit_cast(float, w1.y & 0xffff0000u); } } }
            if (which == 1) {
#pragma unroll
                for (int bj = 0; bj < 2; ++bj)
#pragma unroll
                    for (int n = 0; n < 2; ++n)
#pragma unroll
                        for (int j = 0; j < 4; ++j) { float v = ks[bj][n][j]; v += __shfl_xor(v, 1); v += __shfl_xor(v, 2); v += __shfl_xor(v, 4); v += __shfl_xor(v, 8);
                            if (fr == 0) atomicAdd(KM + ((size_t)((u.pm >> 3) * 8 + 4 * half + 2 * bj + (wc >> 1)) * 8 + (u.pm & 7)) * 64 + dbase + 8 * n + j, v); } }
        } else {
            const int col0 = 256 * (u.pn - 22) + wc * 32 + 8 * fq;
#pragma unroll
            for (int bj = 0; bj < 2; ++bj) { const f32x4 b0 = *(const f32x4*)(bgate + 1024 + col0 + bj * HALF), b1 = *(const f32x4*)(bgate + 1024 + col0 + bj * HALF + 4);
#pragma unroll
                for (int ai = 0; ai < 2; ++ai)
#pragma unroll
                    for (int m = 0; m < 4; ++m) { const f32x4 v0 = acc[ai][bj][m][0] + b0, v1 = acc[ai][bj][m][1] + b1;
                        u32x4 w; w.x = cvt_pk_bf16(sigm_f(v0[0]), sigm_f(v0[1])); w.y = cvt_pk_bf16(sigm_f(v0[2]), sigm_f(v0[3])); w.z = cvt_pk_bf16(sigm_f(v1[0]), sigm_f(v1[1])); w.w = cvt_pk_bf16(sigm_f(v1[2]), sigm_f(v1[3]));
                        *(u32x4*)(GA + (size_t)(row0 + ai * HALF + m * 16) * 1024 + col0 + bj * HALF) = w; } }
        }
    }
};
}

#define XB_TMO      128
#define XB_XCNT(j)  (256  + 64 * (j))
#define XB_XSUB(j)  (1280 + 64 * (j))
#define XB_XGEN(j)  (2304 + 64 * (j))
#define XB_TOP      3328
#define XB_TOPGEN   3392
#define XCD_BAR_WORDS 3456
#define XB_SPIN_CAP (1u << 22)
__device__ __forceinline__ unsigned xb_ld(unsigned* p)              { return __hip_atomic_load(p, __ATOMIC_RELAXED, __HIP_MEMORY_SCOPE_AGENT); }
__device__ __forceinline__ unsigned xb_add(unsigned* p, unsigned v) { return __hip_atomic_fetch_add(p, v, __ATOMIC_RELAXED, __HIP_MEMORY_SCOPE_AGENT); }
__device__ __forceinline__ unsigned xb_xcc_id() { return (unsigned)__builtin_amdgcn_s_getreg((3 << 11) | 20) & 0xFu; }
#define XB_SPIN(cond, bar) do { unsigned _sp = 0; while (cond) { __builtin_amdgcn_s_sleep(1); \
    if ((++_sp & 255u) == 0u) { if (xb_ld(&(bar)[XB_TMO])) break; if (_sp > XB_SPIN_CAP) { atomicAdd(&(bar)[XB_TMO], 1u); break; } } } } while (0)
struct XcdBarrier { unsigned* bar; unsigned x; volatile LAS unsigned* st; };
__device__ __forceinline__ XcdBarrier xcd_barrier_post(unsigned* bar, volatile LAS unsigned* st) {
    XcdBarrier b; b.bar = bar; b.x = xb_xcc_id(); b.st = st;
    if (threadIdx.x == 0) (void)xb_add(&bar[XB_XCNT(b.x)], 1u);
    return b;
}
__device__ __forceinline__ void xcd_barrier_complete(unsigned* bar, unsigned x, unsigned& nloc, unsigned& nx) {
    const unsigned G = gridDim.x * gridDim.y * gridDim.z;
    unsigned sum, cnt, mine, sp = 0u;
    for (;;) {
        sum = 0u; cnt = 0u; mine = 0u;
#pragma unroll
        for (unsigned j = 0; j < 16; ++j) { const unsigned c = xb_ld(&bar[XB_XCNT(j)]); sum += c; cnt += (c > 0u) ? 1u : 0u; mine = (j == x) ? c : mine; }
        if (sum == G) break;
        __builtin_amdgcn_s_sleep(1);
        if ((++sp & 255u) == 0u) { if (xb_ld(&bar[XB_TMO])) break; if (sp > XB_SPIN_CAP) { atomicAdd(&bar[XB_TMO], 1u); break; } }
    }
    nloc = mine > 0u ? mine : 1u; nx = cnt > 0u ? cnt : 1u;
}
__device__ __forceinline__ void xcd_barrier(const XcdBarrier& b) {
    asm volatile("s_waitcnt vmcnt(0)" ::: "memory");
    __syncthreads();
    if (threadIdx.x == 0) {
        unsigned* bar = b.bar;
        __builtin_amdgcn_s_waitcnt(0);
        unsigned nloc = b.st[0], nx = b.st[1];
        if (nloc == 0u) { xcd_barrier_complete(bar, b.x, nloc, nx); b.st[0] = nloc; b.st[1] = nx; }
        const unsigned old = xb_add(&bar[XB_XSUB(b.x)], 1u);
        const unsigned gen = old / nloc;
        if (old + 1u == (gen + 1u) * nloc) {
            __builtin_amdgcn_fence(__ATOMIC_RELEASE, "agent");
            asm volatile("s_waitcnt vmcnt(0)" ::: "memory");
            const unsigned og = xb_add(&bar[XB_TOP], 1u);
            const unsigned tg = og / nx;
            if (og + 1u == (tg + 1u) * nx) xb_add(&bar[XB_TOPGEN], 1u);
            else XB_SPIN(xb_ld(&bar[XB_TOPGEN]) == tg, bar);
            __builtin_amdgcn_fence(__ATOMIC_ACQUIRE, "agent");
            xb_add(&bar[XB_XGEN(b.x)], 1u);
            asm volatile("s_waitcnt vmcnt(0)" ::: "memory");
        } else {
            XB_SPIN(xb_ld(&bar[XB_XGEN(b.x)]) == gen, bar);
            __builtin_amdgcn_fence(__ATOMIC_ACQUIRE, "agent");
            asm volatile("s_waitcnt vmcnt(0)" ::: "memory");
        }
    }
    __syncthreads();
}

constexpr int RING_BYTES = 131072, MISC_OFF = RING_BYTES + 320, LDS_BYTES = 147456;

__constant__ float ROPE_INV[8] = {1.0f, 0.1939227432012558f, 0.03760603070259094f, 0.007292664609849453f, 0.0014142135623842478f, 0.00027424818836152554f, 5.318296098266728e-05f, 1.0313386155758053e-05f};
__device__ __forceinline__ void ph_prologue(Frame& F) {
    float* scr = (float*)(F.lds + F.wave * 16384);
    const int gw = F.vcu * NWAVES + F.wave, NGW = F.G * NWAVES;
    constexpr int I_IN = (D / 64) * (INC / 32), I_CO = (CW / 64) * (D / 32), I_AO = (AW / 64) * (D / 32), I_MX = (D / 64) * (D / 32), I_S1 = (D / 64) * (SD / 32), I_S2 = (SD / 64) * (D / 32);
    constexpr int NIT = I_IN + I_CO + I_AO + I_MX + 2 * I_S1 + I_S2;
    for (int it = gw; it < NIT; it += NGW) {
        int r = it;
        if (r < I_IN) { transpose_item(IN_PTR(1), D, INC, (bf16*)(F.ws + WS_WIN), RMapWin{}, scr, r, F.lane); continue; } r -= I_IN;
        if (r < I_CO) { transpose_item(IN_PTR(4), CW, D, (bf16*)(F.ws + WS_WCO), RMapId{0}, scr, r, F.lane); continue; } r -= I_CO;
        if (r < I_AO) { transpose_item(IN_PTR(5), AW, D, (bf16*)(F.ws + WS_WAO), RMapId{0}, scr, r, F.lane); continue; } r -= I_AO;
        if (r < I_MX) { transpose_item(IN_PTR(6), D, D, (bf16*)(F.ws + WS_WMIX), RMapId{0}, scr, r, F.lane); continue; } r -= I_MX;
        if (r < I_S1) { transpose_item(IN_PTR(14), D, SD, (bf16*)(F.ws + WS_WS13), RMap13{0}, scr, r, F.lane); continue; } r -= I_S1;
        if (r < I_S1) { transpose_item(IN_PTR(15), D, SD, (bf16*)(F.ws + WS_WS13), RMap13{1}, scr, r, F.lane); continue; } r -= I_S1;
        transpose_item(IN_PTR(16), SD, D, (bf16*)(F.ws + WS_WS2), RMapId{0}, scr, r, F.lane);
    }
    { const float* Wr = IN_PTR(9); bf16* W3 = (bf16*)(F.ws + WS_WR3); const int gt = blockIdx.x * NTHR + F.tid, NT_ = F.G * NTHR;
      for (int i = gt; i < D * NE; i += NT_) { const int n = i & 255, k = i >> 8; const float w = Wr[i]; const unsigned hi = f2bf(w), lo = f2bf(w - bf2f(hi));
          bf16* r = W3 + (size_t)n * 3072 + k; r[0] = (bf16)hi; r[1024] = (bf16)hi; r[2048] = (bf16)lo; } }
    { const int gt = blockIdx.x * NTHR + F.tid, NT_ = F.G * NTHR; float* rc = (float*)(F.ws + WS_ROPE); float* km = (float*)(F.ws + WS_KMEAN);
      for (int i = gt; i < SEQ * 8; i += NT_) { const float ang = (float)(i >> 3) * ROPE_INV[i & 7]; rc[i] = cosf(ang); rc[SEQ * 8 + i] = sinf(ang); }
      for (int i = gt; i < NB * NH * NBLK * HD; i += NT_) km[i] = 0.f; }
    const f32x4* x4 = (const f32x4*)IN_PTR(0); u32x2* xb = (u32x2*)(F.ws + WS_XB);
    const size_t n4 = (size_t)T * D / 4, gt = (size_t)blockIdx.x * NTHR + F.tid, NT_ = (size_t)F.G * NTHR;
    for (size_t i = gt; i < n4; i += NT_) { const f32x4 v = x4[i]; u32x2 o; o.x = pk2(v.x, v.y); o.y = pk2(v.z, v.w); xb[i] = o; }
}

__device__ __forceinline__ void ph_expert_weights(Frame& F) {
    float* scr = (float*)(F.lds + F.wave * 16384);
    const int gw = F.vcu * NWAVES + F.wave, NGW = F.G * NWAVES;
    constexpr int I1 = (D / 64) * (ED / 32), I2 = (ED / 64) * (D / 32), IPE = 2 * I1 + I2;
    for (int it = gw; it < NE * IPE; it += NGW) {
        const int e = it / IPE; int r = it % IPE;
        bf16* w13 = (bf16*)(F.ws + WS_W13T) + (size_t)e * 512 * 1024; bf16* w2 = (bf16*)(F.ws + WS_W2T) + (size_t)e * 1024 * 256;
        if (r < I1) { transpose_item(IN_PTR(11) + (size_t)e * D * ED, D, ED, w13, RMap13{0}, scr, r, F.lane); continue; } r -= I1;
        if (r < I1) { transpose_item(IN_PTR(12) + (size_t)e * D * ED, D, ED, w13, RMap13{1}, scr, r, F.lane); continue; } r -= I1;
        transpose_item(IN_PTR(13) + (size_t)e * ED * D, ED, D, w2, RMapId{0}, scr, r, F.lane);
    }
    constexpr int I_S1 = (D / 64) * (SD / 32), I_S2 = (SD / 64) * (D / 32);
    bf16* w13 = (bf16*)(F.ws + WS_W13T) + (size_t)NE * 512 * 1024; bf16* w2 = (bf16*)(F.ws + WS_W2T) + (size_t)NE * 1024 * 256;
    for (int it = gw; it < 2 * I_S1 + I_S2; it += NGW) {
        int r = it;
        if (r < I_S1) { transpose_item(IN_PTR(14), D, SD, w13, RMap13{0}, scr, r, F.lane); continue; } r -= I_S1;
        if (r < I_S1) { transpose_item(IN_PTR(15), D, SD, w13, RMap13{1}, scr, r, F.lane); continue; } r -= I_S1;
        transpose_item(IN_PTR(16), SD, D, w2, RMapId{0}, scr, r, F.lane);
    }
}

__device__ __forceinline__ void ph_gemm1_simple(Frame& F) {
    const bf16* XB = (const bf16*)(F.ws + WS_XB); const bf16* W = (const bf16*)(F.ws + WS_WIN); bf16* P = (bf16*)(F.ws + WS_PROJ);
    constexpr int NTM = T / 128, NTN = INC / 128;
    for (int it = F.vcu; it < NTM * NTN; it += F.G) {
        const int tm = it / NTN, tn = it % NTN;
        const bf16* A0 = XB + (size_t)tm * 128 * D;
        sg_tile<false>([&](int r) { return A0 + (size_t)r * D; }, W + (size_t)tn * 128 * D, nullptr, D, D, F.wave, F.lane,
            [&](int r, int c, float v, float) { P[(size_t)(tm * 128 + r) * INC + tn * 128 + c] = (bf16)f2bf(v); });
    }
}

__device__ __forceinline__ void ph_post1_simple(Frame& F) {
    const bf16* P = (const bf16*)(F.ws + WS_PROJ);
    bf16* Q = (bf16*)(F.ws + WS_Q); bf16* K = (bf16*)(F.ws + WS_K); bf16* V = (bf16*)(F.ws + WS_V);
    bf16* GC = (bf16*)(F.ws + WS_GC); bf16* GA = (bf16*)(F.ws + WS_GA); bf16* AC = (bf16*)(F.ws + WS_AC);
    const float* bg = IN_PTR(2); const float* wc = IN_PTR(3);
    const size_t gt = (size_t)blockIdx.x * NTHR + F.tid, NT_ = (size_t)F.G * NTHR;
    for (size_t i = gt; i < (size_t)T * 1024; i += NT_) {
        const int t = (int)(i >> 10), c = (int)(i & 1023), s = t & (SEQ - 1);
        const bf16* pr = P + (size_t)t * INC;
        float y = 0.f;
#pragma unroll
        for (int j = 0; j < 3; ++j) { const int d = 2 - j; if (s - d >= 0) { const bf16* pp = pr - (size_t)d * INC; y += wc[j * CW + c] * (bf2f(pp[C_CC + c]) * bf2f(pp[C_CV + c])); } }
        AC[i] = (bf16)f2bf(bf2f(pr[C_CB + c]) * y);
        GC[i] = (bf16)f2bf(sigmoidf_(bf2f(pr[C_GC + c]) + bg[c]));
        GA[i] = (bf16)f2bf(sigmoidf_(bf2f(pr[C_GA + c]) + bg[D + c]));
    }
    for (size_t i = gt; i < (size_t)T * AW; i += NT_) {
        const int t = (int)(i >> 9), c = (int)(i & 511), d = c & 63, s = t & (SEQ - 1);
        const bf16* pr = P + (size_t)t * INC;
        float q = bf2f(pr[C_Q + c]), k = bf2f(pr[C_K + c]);
        if (d < 16) {
            const int fi = d & 7; const float ang = (float)s * ROPE_INV[fi]; const float cs = cosf(ang), sn = sinf(ang);
            const int pc = (d < 8) ? c + 8 : c - 8; const float q2 = bf2f(pr[C_Q + pc]), k2 = bf2f(pr[C_K + pc]);
            if (d < 8) { q = q * cs - q2 * sn; k = k * cs - k2 * sn; } else { q = q * cs + q2 * sn; k = k * cs + k2 * sn; }
        }
        Q[i] = (bf16)f2bf(q * QSCALE); K[i] = (bf16)f2bf(k); V[i] = pr[C_V + c];
    }
}

__device__ __forceinline__ void ph_conv_fixup(Frame& F) {
    const float* UH = (const float*)(F.ws + WS_UH); const float* CBH = (const float*)(F.ws + WS_CBH); const float* wc = IN_PTR(3); bf16* AC = (bf16*)(F.ws + WS_AC);
    const int gt = blockIdx.x * NTHR + F.tid, NT_ = F.G * NTHR;
    for (int i = gt; i < (T / 256) * 2 * 1024; i += NT_) {
        const int c = i & 1023, r = (i >> 10) & 1, pm = i >> 11;
        if ((pm & 7) == 0) continue;
        const float um2 = UH[((size_t)(pm - 1) * 2 + 0) * 1024 + c], um1 = UH[((size_t)(pm - 1) * 2 + 1) * 1024 + c], cb = CBH[((size_t)pm * 2 + r) * 1024 + c];
        const float extra = (r == 0) ? cb * (wc[c] * um2 + wc[1024 + c] * um1) : cb * (wc[c] * um1);
        const size_t o = (size_t)(pm * 256 + r) * 1024 + c; AC[o] = (bf16)f2bf(bf2f(AC[o]) + extra);
    }
}

__device__ __forceinline__ void ph_kmean_simple(Frame& F) {
    const bf16* K = (const bf16*)(F.ws + WS_K); float* KM = (float*)(F.ws + WS_KMEAN);
    const int gt = blockIdx.x * NTHR + F.tid, NT_ = F.G * NTHR;
    for (int i = gt; i < NB * NH * NBLK * HD; i += NT_) {
        const int d = i & 63, blk = (i >> 6) & 7, h = (i >> 9) & 7, b = i >> 12;
        const bf16* kp = K + (size_t)(b * SEQ + blk * MBLK) * AW + h * HD + d; float s = 0.f;
        for (int r = 0; r < MBLK; ++r) s += bf2f(kp[(size_t)r * AW]);
        KM[i] = s * (1.0f / MBLK);
    }
}

__device__ __forceinline__ void ph_attn_simple(Frame& F) {
    const bf16* Q = (const bf16*)(F.ws + WS_Q); const bf16* K = (const bf16*)(F.ws + WS_K); const bf16* V = (const bf16*)(F.ws + WS_V);
    const float* KM = (const float*)(F.ws + WS_KMEAN); bf16* O = (bf16*)(F.ws + WS_O);
    const int gt = blockIdx.x * NTHR + F.tid, NT_ = F.G * NTHR;
    for (int i = gt; i < NB * NH * SEQ; i += NT_) {
        const int s = i & (SEQ - 1), bh = i >> 11, h = bh & 7, b = bh >> 3, blk = s >> 8;
        const size_t trow = (size_t)(b * SEQ + s);
        bf16x8 q8[8]; float o[64];
        { const bf16x8* qp = (const bf16x8*)(Q + trow * AW + h * HD);
#pragma unroll
          for (int c8 = 0; c8 < 8; ++c8) q8[c8] = qp[c8]; }
#pragma unroll
        for (int d = 0; d < 64; ++d) o[d] = 0.f;
        unsigned sel = 0u;
        if (blk <= 3) sel = (1u << blk) - 1u;
        else {
            float v0 = -INFINITY, v1 = -INFINITY, v2 = -INFINITY; int i0 = 0, i1 = 0, i2 = 0;
#pragma unroll 1
            for (int j = 0; j < blk; ++j) { const float* km = KM + ((size_t)(bh * NBLK + j)) * HD; float a = 0.f;
#pragma unroll
                for (int c8 = 0; c8 < 8; ++c8) { const f32x4 ka = *(const f32x4*)(km + c8 * 8), kb2 = *(const f32x4*)(km + c8 * 8 + 4);
                    a += bf2f((unsigned short)q8[c8][0]) * ka.x + bf2f((unsigned short)q8[c8][1]) * ka.y + bf2f((unsigned short)q8[c8][2]) * ka.z + bf2f((unsigned short)q8[c8][3]) * ka.w;
                    a += bf2f((unsigned short)q8[c8][4]) * kb2.x + bf2f((unsigned short)q8[c8][5]) * kb2.y + bf2f((unsigned short)q8[c8][6]) * kb2.z + bf2f((unsigned short)q8[c8][7]) * kb2.w; }
                if (a > v0) { v2 = v1; i2 = i1; v1 = v0; i1 = i0; v0 = a; i0 = j; }
                else if (a > v1) { v2 = v1; i2 = i1; v1 = a; i1 = j; }
                else if (a > v2) { v2 = a; i2 = j; } }
            sel = (1u << i0) | (1u << i1) | (1u << i2);
        }
        float m = -INFINITY, l = 0.f;
        for (int jj = 0; jj <= blk; ++jj) {
            const int j = (jj == 0) ? blk : jj - 1;
            const bool act = (j == blk) || ((sel >> j) & 1u);
            if (!__any(act)) continue;
            const int kend = (j == blk) ? (s & 255) : 255;
            const bf16* kb = K + (size_t)(b * SEQ + j * MBLK) * AW + h * HD; const bf16* vb = V + (size_t)(b * SEQ + j * MBLK) * AW + h * HD;
#pragma unroll 1
            for (int k0 = 0; k0 < MBLK; ++k0) {
                const bf16x8* kp = (const bf16x8*)(kb + (size_t)k0 * AW); float a = 0.f;
#pragma unroll
                for (int c8 = 0; c8 < 8; ++c8) { const bf16x8 v = kp[c8];
#pragma unroll
                    for (int e = 0; e < 8; ++e) a += bf2f((unsigned short)q8[c8][e]) * bf2f((unsigned short)v[e]); }
                const float sc = (act && k0 <= kend) ? a : -INFINITY;
                if (sc > m) { const float corr = exp2f(m - sc); l *= corr;
#pragma unroll
                    for (int d = 0; d < 64; ++d) o[d] *= corr; m = sc; }
                const float p = exp2f(sc - m); l += p; const bf16x8* vp = (const bf16x8*)(vb + (size_t)k0 * AW);
#pragma unroll
                for (int c8 = 0; c8 < 8; ++c8) { const bf16x8 v = vp[c8];
#pragma unroll
                    for (int e = 0; e < 8; ++e) o[c8 * 8 + e] += p * bf2f((unsigned short)v[e]); }
            }
        }
        const float rl = 1.0f / l; u32x4* op = (u32x4*)(O + trow * AW + h * HD);
#pragma unroll
        for (int c8 = 0; c8 < 8; ++c8) { u32x4 w; w.x = pk2(o[c8 * 8 + 0] * rl, o[c8 * 8 + 1] * rl); w.y = pk2(o[c8 * 8 + 2] * rl, o[c8 * 8 + 3] * rl); w.z = pk2(o[c8 * 8 + 4] * rl, o[c8 * 8 + 5] * rl); w.w = pk2(o[c8 * 8 + 6] * rl, o[c8 * 8 + 7] * rl); op[c8] = w; }
    }
}

__device__ __forceinline__ void ph_branch_out_simple(Frame& F) {
    const bf16* AC = (const bf16*)(F.ws + WS_AC); const bf16* O = (const bf16*)(F.ws + WS_O);
    const bf16* GC = (const bf16*)(F.ws + WS_GC); const bf16* GA = (const bf16*)(F.ws + WS_GA);
    const bf16* Wco = (const bf16*)(F.ws + WS_WCO); const bf16* Wao = (const bf16*)(F.ws + WS_WAO); bf16* MX = (bf16*)(F.ws + WS_MIXED);
    float* tmp = F.out;
    constexpr int NTM = T / 128, NTN = D / 128;
    for (int it = F.vcu; it < NTM * NTN; it += F.G) {
        const int tm = it / NTN, tn = it % NTN;
        const bf16* A0 = AC + (size_t)tm * 128 * CW;
        sg_tile<false>([&](int r) { return A0 + (size_t)r * CW; }, Wco + (size_t)tn * 128 * CW, nullptr, CW, CW, F.wave, F.lane,
            [&](int r, int c, float v, float) { const size_t o = (size_t)(tm * 128 + r) * D + tn * 128 + c; tmp[o] = bf2f(GC[o]) * v; });
        const bf16* A1 = O + (size_t)tm * 128 * AW;
        sg_tile<false>([&](int r) { return A1 + (size_t)r * AW; }, Wao + (size_t)tn * 128 * AW, nullptr, AW, AW, F.wave, F.lane,
            [&](int r, int c, float v, float) { const size_t o = (size_t)(tm * 128 + r) * D + tn * 128 + c; MX[o] = (bf16)f2bf(tmp[o] + bf2f(GA[o]) * v); });
    }
}

__device__ __forceinline__ void ph_mix_simple(Frame& F) {
    const bf16* MX = (const bf16*)(F.ws + WS_MIXED); const bf16* W = (const bf16*)(F.ws + WS_WMIX); const float* x = IN_PTR(0); float* hp = F.out;
    constexpr int NTM = T / 128, NTN = D / 128;
    for (int it = F.vcu; it < NTM * NTN; it += F.G) {
        const int tm = it / NTN, tn = it % NTN;
        const bf16* A0 = MX + (size_t)tm * 128 * D;
        sg_tile<false>([&](int r) { return A0 + (size_t)r * D; }, W + (size_t)tn * 128 * D, nullptr, D, D, F.wave, F.lane,
            [&](int r, int c, float v, float) { const size_t o = (size_t)(tm * 128 + r) * D + tn * 128 + c; hp[o] = ALPHA * x[o] + v; });
    }
}

__device__ __forceinline__ void ph_ln1_simple(Frame& F) {
    const float* hp = F.out; const float* g = IN_PTR(7); const float* bta = IN_PTR(8);
    bf16* HI = (bf16*)(F.ws + WS_H1HI); bf16* LO = (bf16*)(F.ws + WS_H1LO);
    const int gw = F.vcu * NWAVES + F.wave, NGW = F.G * NWAVES;
    for (int m = gw; m < T; m += NGW) {
        const f32x4* xr = (const f32x4*)(hp + (size_t)m * D) + F.lane;
        f32x4 v[4]; float s = 0.f;
#pragma unroll
        for (int j = 0; j < 4; ++j) { v[j] = xr[64 * j]; s += (v[j].x + v[j].y) + (v[j].z + v[j].w); }
        const float mean = wave_sum(s) * (1.f / D); float s2 = 0.f;
#pragma unroll
        for (int j = 0; j < 4; ++j) { v[j] = v[j] - mean; s2 += (v[j].x * v[j].x + v[j].y * v[j].y) + (v[j].z * v[j].z + v[j].w * v[j].w); }
        const float rstd = 1.f / sqrtf(wave_sum(s2) * (1.f / D) + LN_EPS);
#pragma unroll
        for (int j = 0; j < 4; ++j) { const int c = 4 * F.lane + 256 * j; const f32x4 gg = *(const f32x4*)(g + c), bb = *(const f32x4*)(bta + c);
            const f32x4 h = v[j] * rstd * gg + bb;
            u32x2 hi, lo; hi.x = pk2(h.x, h.y); hi.y = pk2(h.z, h.w);
            lo.x = pk2(h.x - bf2f(hi.x & 0xffffu), h.y - bf2f(hi.x >> 16)); lo.y = pk2(h.z - bf2f(hi.y & 0xffffu), h.w - bf2f(hi.y >> 16));
            *(u32x2*)(HI + (size_t)m * D + c) = hi; *(u32x2*)(LO + (size_t)m * D + c) = lo; }
    }
}

__device__ __forceinline__ void route_token(Frame& F, int t, f32x4 logit, const float* rbias, bool commit = true) {
    const int lane = F.lane;
    int* CNT = (int*)(F.ws + WS_CTL) + CW_CNT; int* BIN = (int*)(F.ws + WS_BIN);
    int* TOPE = (int*)(F.ws + WS_TOPE); int* TOPP = (int*)(F.ws + WS_TOPP); float* TOPW = (float*)(F.ws + WS_TOPW);
    float sc[4], bs[4];
    const f32x4 rb = *(const f32x4*)(rbias + 4 * lane);
#pragma unroll
    for (int j = 0; j < 4; ++j) { sc[j] = sigmoidf_(logit[j]); bs[j] = sc[j] + rb[j]; }
    float m1 = fmaxf(bs[0], bs[1]), m2 = fminf(bs[0], bs[1]);
#pragma unroll
    for (int j = 2; j < 4; ++j) { const float v = bs[j]; m2 = fmaxf(m2, fminf(m1, v)); m1 = fmaxf(m1, v); }
#pragma unroll
    for (int o = 1; o < 8; o <<= 1) { const float o1 = __shfl_xor(m1, o), o2 = __shfl_xor(m2, o); const float n1 = fmaxf(m1, o1), n2 = fmaxf(fminf(m1, o1), fmaxf(m2, o2)); m1 = n1; m2 = n2; }
    const float gs = m1 + m2; const int myg = lane >> 3;
    int rank = 0;
#pragma unroll
    for (int g2 = 0; g2 < 8; ++g2) { const float og = __shfl(gs, g2 * 8); rank += (og > gs || (og == gs && g2 < myg)) ? 1 : 0; }
    const bool gsel = rank < TOPG;
    float mv[4];
#pragma unroll
    for (int j = 0; j < 4; ++j) mv[j] = gsel ? bs[j] : -INFINITY;
    int my_e = -1; float my_w = 0.f; float wsum = 0.f;
#pragma unroll 1
    for (int k = 0; k < TOPK; ++k) {
        float bv = mv[0]; int bi = 4 * lane;
#pragma unroll
        for (int j = 1; j < 4; ++j) if (mv[j] > bv) { bv = mv[j]; bi = 4 * lane + j; }
#pragma unroll
        for (int o = 1; o < 64; o <<= 1) { const float ov = __shfl_xor(bv, o); const int oi = __shfl_xor(bi, o); if (ov > bv || (ov == bv && oi < bi)) { bv = ov; bi = oi; } }
        const int ol = bi >> 2, oj = bi & 3;
        float sv = (oj == 0) ? sc[0] : (oj == 1) ? sc[1] : (oj == 2) ? sc[2] : sc[3];
        sv = __shfl(sv, ol);
        if (lane == ol) { if (oj == 0) mv[0] = -INFINITY; else if (oj == 1) mv[1] = -INFINITY; else if (oj == 2) mv[2] = -INFINITY; else mv[3] = -INFINITY; }
        if (lane == k) { my_e = bi; my_w = sv; }
        wsum += sv;
    }
    if (lane < TOPK && commit) {
        const int pos = atomicAdd(&CNT[my_e], 1);
        BIN[(size_t)my_e * T + pos] = t;
        TOPE[t * TOPK + lane] = my_e; TOPP[t * TOPK + lane] = pos; TOPW[t * TOPK + lane] = my_w / wsum * RSCALE;
    }
}
__device__ __forceinline__ void ph_router_simple(Frame& F, bool commit = true) {
    const bf16* HI = (const bf16*)(F.ws + WS_H1HI); const bf16* LO = (const bf16*)(F.ws + WS_H1LO);
    const float* Wr = IN_PTR(9); const float* rbias = IN_PTR(10);
    const int gw = F.vcu * NWAVES + F.wave, NGW = F.G * NWAVES;
    for (int t0 = gw * 8; t0 < T; t0 += NGW * 8) {
        f32x4 acc[8];
#pragma unroll
        for (int i = 0; i < 8; ++i) acc[i] = (f32x4){0.f, 0.f, 0.f, 0.f};
        for (int k0 = 0; k0 < D; k0 += 64) {
            float hv[8];
#pragma unroll
            for (int i = 0; i < 8; ++i) { const size_t o = (size_t)(t0 + i) * D + k0 + F.lane; hv[i] = bf2f(HI[o]) + bf2f(LO[o]); }
#pragma unroll 8
            for (int kk = 0; kk < 64; ++kk) {
                const f32x4 w = *(const f32x4*)(Wr + (size_t)(k0 + kk) * NE + 4 * F.lane);
#pragma unroll
                for (int i = 0; i < 8; ++i) { const float hb = __builtin_bit_cast(float, __builtin_amdgcn_readlane(__builtin_bit_cast(int, hv[i]), kk)); acc[i] += w * hb; }
            }
        }
#pragma unroll
        for (int i = 0; i < 8; ++i) route_token(F, t0 + i, acc[i], rbias, commit);
    }
}

__device__ __forceinline__ void ph_router_gemm(Frame& F) {
    pg8::RouterSched S; S.G = F.G; S.c = F.vcu; S.W = (const char*)(F.ws + WS_WR3); S.lo_off = WS_H1LO - WS_H1HI;
    pg8::EpiLogits E{(float*)(F.ws + WS_LOGITS)};
    pg8::gemm_phase_x<pg8::EpiLogits, pg8::RouterSched, 3072>((LAS unsigned char*)F.lds, (const char*)(F.ws + WS_H1HI), S, E);
}
__device__ __forceinline__ void ph_routing(Frame& F) {
    const float* LG = (const float*)(F.ws + WS_LOGITS); const float* rbias = IN_PTR(10);
    const int gw = F.vcu * NWAVES + F.wave, NGW = F.G * NWAVES;
    for (int t = gw; t < T; t += NGW) route_token(F, t, *(const f32x4*)(LG + (size_t)t * NE + 4 * F.lane), rbias);
}

template <int TR> __device__ __forceinline__ void build_tables(Frame& F, int* cnt, int* base, int* tb) {
    const int* CNT = (const int*)(F.ws + WS_CTL) + CW_CNT;
    __syncthreads();
    for (int e = F.tid; e < NE + 1; e += NTHR) cnt[e] = (e < NE) ? __hip_atomic_load(CNT + e, __ATOMIC_RELAXED, __HIP_MEMORY_SCOPE_AGENT) : T;
    __syncthreads();
    if (F.tid == 0) { int b = 0, t = 0; for (int e = 0; e <= NE; ++e) { base[e] = b; tb[e] = t; b += cnt[e]; t += (cnt[e] + TR - 1) / TR; } base[NE + 1] = b; tb[NE + 1] = t; }
    __syncthreads();
}
__device__ __forceinline__ int find_expert(const int* tb, int tile) {
    int lo = 0, hi = NE;
    while (lo < hi) { const int mid = (lo + hi + 1) >> 1; if (tb[mid] <= tile) lo = mid; else hi = mid - 1; }
    return lo;
}

__device__ __forceinline__ void ph_up_simple(Frame& F) {
    int* cnt = (int*)(F.lds); int* base = cnt + 320; int* tb = base + 320;
    build_tables<128>(F, cnt, base, tb);
    const bf16* HI = (const bf16*)(F.ws + WS_H1HI); const int* BIN = (const int*)(F.ws + WS_BIN);
    const bf16* W13 = (const bf16*)(F.ws + WS_W13T); bf16* HID = (bf16*)(F.ws + WS_HID);
    const int ntile = tb[NE + 1];
    for (int it = F.vcu; it < ntile * 2; it += F.G) {
        const int tile = it >> 1, pn = it & 1, e = find_expert(tb, tile), rt = tile - tb[e], ce = cnt[e], r0 = rt * 128;
        const int* bin = BIN + (size_t)e * T;
        const bf16* B1 = W13 + (size_t)e * 512 * 1024 + (size_t)(256 * pn) * 1024;
        sg_tile<true>([&](int r) { int rr = r0 + r; if (rr >= ce) rr = ce - 1; const int tok = (e < NE) ? bin[rr] : rr; return HI + (size_t)tok * D; },
            B1, B1 + (size_t)128 * 1024, 1024, D, F.wave, F.lane,
            [&](int r, int c, float v1, float v3) { if (r0 + r < ce) { const float hsw = v1 * sigmoidf_(v1) * v3; HID[(size_t)(base[e] + r0 + r) * ED + 128 * pn + c] = (bf16)f2bf(hsw); } });
    }
}
__device__ __forceinline__ void ph_down_simple(Frame& F) {
    int* cnt = (int*)(F.lds); int* base = cnt + 320; int* tb = base + 320;
    build_tables<128>(F, cnt, base, tb);
    const bf16* HID = (const bf16*)(F.ws + WS_HID); const bf16* W2 = (const bf16*)(F.ws + WS_W2T); bf16* Y = (bf16*)(F.ws + WS_Y);
    const int ntile = tb[NE + 1];
    for (int it = F.vcu; it < ntile * 8; it += F.G) {
        const int tile = it >> 3, pn = it & 7, e = find_expert(tb, tile), rt = tile - tb[e], ce = cnt[e], r0 = rt * 128;
        const bf16* A0 = HID + (size_t)base[e] * ED;
        sg_tile<false>([&](int r) { int rr = r0 + r; if (rr >= ce) rr = ce - 1; return A0 + (size_t)rr * ED; },
            W2 + (size_t)e * 1024 * 256 + (size_t)(128 * pn) * 256, nullptr, 256, ED, F.wave, F.lane,
            [&](int r, int c, float v, float) { if (r0 + r < ce) Y[(size_t)(base[e] + r0 + r) * D + 128 * pn + c] = (bf16)f2bf(v); });
    }
}
constexpr int TAB_OFF = RING_BYTES + 1024, ULIST_OFF = TAB_OFF + 4096;
__device__ __forceinline__ void build_unit_list(Frame& F, const int* cnt, const int* base, const int* tb, int npn) {
    int* U = (int*)(F.lds + ULIST_OFF);
    const int nitem = tb[NE + 1] * npn;
    if (F.tid < pg8::GroupSched::MAXU) {
        const int item = F.tid * F.G + F.vcu; int e = -1, rt = 0, pn = 0;
        if (item < nitem) { int lo = 0, hi = NE;
            while (lo < hi) { const int mid = (lo + hi + 1) >> 1; if (tb[mid] * npn <= item) lo = mid; else hi = mid - 1; }
            e = lo; const int nte = tb[e + 1] - tb[e], li = item - tb[e] * npn; pn = li / nte; rt = li % nte; }
        U[F.tid * 8 + 0] = e; U[F.tid * 8 + 1] = rt; U[F.tid * 8 + 2] = pn; U[F.tid * 8 + 3] = (e >= 0) ? cnt[e] : 0; U[F.tid * 8 + 4] = (e >= 0) ? base[e] + rt * 256 : 0;
    }
    __syncthreads();
}
__device__ __forceinline__ void ph_up_fast(Frame& F) {
    int* cnt = (int*)(F.lds + TAB_OFF); int* base = cnt + 320; int* tb = base + 320;
    build_tables<256>(F, cnt, base, tb); build_unit_list(F, cnt, base, tb, 2);
    pg8::GroupSched S; S.U = (const LAS int*)((LAS unsigned char*)F.lds + ULIST_OFF);
    S.BIN = (const int*)(F.ws + WS_BIN); S.W = (const char*)(F.ws + WS_W13T); S.wse = (size_t)512 * 1024 * 2; S.wsp = (size_t)256 * 1024 * 2; S.rowbytes = D * 2;
    pg8::EpiSwiglu E{(bf16*)(F.ws + WS_HID)};
    pg8::gemm_phase_x<pg8::EpiSwiglu, pg8::GroupSched, D>((LAS unsigned char*)F.lds, (const char*)(F.ws + WS_H1HI), S, E);
}
__device__ __forceinline__ void ph_down_fast(Frame& F) {
    int* cnt = (int*)(F.lds + TAB_OFF); int* base = cnt + 320; int* tb = base + 320;
    build_tables<256>(F, cnt, base, tb); build_unit_list(F, cnt, base, tb, 4);
    pg8::GroupSched S; S.U = (const LAS int*)((LAS unsigned char*)F.lds + ULIST_OFF);
    S.BIN = nullptr; S.W = (const char*)(F.ws + WS_W2T); S.wse = (size_t)1024 * 256 * 2; S.wsp = (size_t)256 * 256 * 2; S.rowbytes = ED * 2;
    pg8::EpiRowsBf16 E{(bf16*)(F.ws + WS_Y), D};
    pg8::gemm_phase_x<pg8::EpiRowsBf16, pg8::GroupSched, ED>((LAS unsigned char*)F.lds, (const char*)(F.ws + WS_HID), S, E);
}
__device__ __forceinline__ void ph_final_simple(Frame& F) {
    int* cnt = (int*)(F.lds); int* base = cnt + 320; int* tb = base + 320;
    build_tables<128>(F, cnt, base, tb);
    const bf16* HI = (const bf16*)(F.ws + WS_H1HI); const bf16* LO = (const bf16*)(F.ws + WS_H1LO); const bf16* Y = (const bf16*)(F.ws + WS_Y);
    const int* TOPE = (const int*)(F.ws + WS_TOPE); const int* TOPP = (const int*)(F.ws + WS_TOPP); const float* TOPW = (const float*)(F.ws + WS_TOPW);
    const float* g = IN_PTR(17); const float* bta = IN_PTR(18);
    const int gw = F.vcu * NWAVES + F.wave, NGW = F.G * NWAVES;
    for (int t = gw; t < T; t += NGW) {
        f32x4 v[4];
#pragma unroll
        for (int j = 0; j < 4; ++j) { const int c = 4 * F.lane + 256 * j; const u32x2 hi = *(const u32x2*)(HI + (size_t)t * D + c), lo = *(const u32x2*)(LO + (size_t)t * D + c);
            v[j].x = ALPHA * (bf2f(hi.x & 0xffffu) + bf2f(lo.x & 0xffffu)); v[j].y = ALPHA * (bf2f(hi.x >> 16) + bf2f(lo.x >> 16));
            v[j].z = ALPHA * (bf2f(hi.y & 0xffffu) + bf2f(lo.y & 0xffffu)); v[j].w = ALPHA * (bf2f(hi.y >> 16) + bf2f(lo.y >> 16)); }
        for (int k = 0; k <= TOPK; ++k) {
            int slot; float w;
            if (k < TOPK) { const int e = TOPE[t * TOPK + k]; slot = base[e] + TOPP[t * TOPK + k]; w = TOPW[t * TOPK + k]; } else { slot = NA + t; w = 1.0f; }
#pragma unroll
            for (int j = 0; j < 4; ++j) { const int c = 4 * F.lane + 256 * j; const u32x2 y = *(const u32x2*)(Y + (size_t)slot * D + c);
                v[j].x += w * bf2f(y.x & 0xffffu); v[j].y += w * bf2f(y.x >> 16); v[j].z += w * bf2f(y.y & 0xffffu); v[j].w += w * bf2f(y.y >> 16); }
        }
        float s = 0.f;
#pragma unroll
        for (int j = 0; j < 4; ++j) s += (v[j].x + v[j].y) + (v[j].z + v[j].w);
        const float mean = wave_sum(s) * (1.f / D); float s2 = 0.f;
#pragma unroll
        for (int j = 0; j < 4; ++j) { v[j] = v[j] - mean; s2 += (v[j].x * v[j].x + v[j].y * v[j].y) + (v[j].z * v[j].z + v[j].w * v[j].w); }
        const float rstd = 1.f / sqrtf(wave_sum(s2) * (1.f / D) + LN_EPS);
#pragma unroll
        for (int j = 0; j < 4; ++j) { const int c = 4 * F.lane + 256 * j; const f32x4 gg = *(const f32x4*)(g + c), bb = *(const f32x4*)(bta + c);
            *(f32x4*)(F.out + (size_t)t * D + c) = v[j] * rstd * gg + bb; }
    }
}

constexpr int N_PHASES = 13;
__global__ void __launch_bounds__(NTHR, 2) fwd_kernel(Args args) {
    extern __shared__ __attribute__((aligned(16))) unsigned char lds[];
    Frame F;
    F.lds = lds; F.tid = threadIdx.x; F.lane = F.tid & 63; F.wave = __builtin_amdgcn_readfirstlane(F.tid >> 6);
    F.G = gridDim.x; { const int bx = blockIdx.x; F.vcu = (F.G % 8 == 0) ? (bx % 8) * (F.G / 8) + bx / 8 : bx; }
    F.out = args.out; F.ws = args.ws;
    volatile LAS unsigned* MISC = (volatile LAS unsigned*)((LAS unsigned char*)lds + MISC_OFF);
    if (F.tid < 32) MISC[F.tid] = 0u;
    __syncthreads();
#if MK_SINGLE
    XcdBarrier bar = xcd_barrier_post((unsigned*)(F.ws + WS_CTL) + CW_BAR, MISC + 8);
#define SEAM() xcd_barrier(bar)
#else
#define SEAM() do {} while (0)
#endif
    const int lo = args.ph_lo, hi = args.ph_hi;
#define IN(k) (lo <= (k) && (k) < hi)
#define BOTH(k) (IN(k) && IN((k) + 1))
    if (IN(0))  { if (DUP_PHASE == 0) { ph_prologue(F); SEAM(); } ph_prologue(F);          if (BOTH(0))  SEAM(); }
    if (IN(1))  {
        pg8::Gemm g{(const bf16*)(F.ws + WS_XB), (const bf16*)(F.ws + WS_WIN), T, INC, D}; pg8::StaticOrder S; S.init(T, INC, F.G, (int)blockIdx.x);
        pg8::EpiProj E{F.ws, (LAS unsigned char*)lds + RING_BYTES + 1024};
        pg8::gemm_phase<pg8::EpiProj, pg8::StaticOrder, true, true>((LAS unsigned char*)lds, g, S, E);
        if (BOTH(1))  SEAM(); }
    if (IN(2))  { ph_conv_fixup(F); }
    if (IN(4))  {
        const attn_body::AttnTensors AT{(const attn_body::bf16*)(F.ws + WS_Q), (const attn_body::bf16*)(F.ws + WS_K), (const attn_body::bf16*)(F.ws + WS_V), (attn_body::bf16*)(F.ws + WS_O), (const float*)(F.ws + WS_KMEAN)};
        const attn_body::MobaOrder S((int)F.G, F.vcu);
        attn_body::attn_phase<attn_body::MobaOrder>((char*)lds, AT, S);
        if (BOTH(4))  SEAM(); }
    if (IN(5))  {
        { pg8::Gemm g{(const bf16*)(F.ws + WS_AC), (const bf16*)(F.ws + WS_WCO), T, D, CW}; pg8::StaticOrder S; S.init(T, D, F.G, (int)blockIdx.x);
          pg8::EpiGateBf16<false> E{(bf16*)(F.ws + WS_MIXED), (const bf16*)(F.ws + WS_GC), D};
          pg8::gemm_phase<pg8::EpiGateBf16<false>, pg8::StaticOrder, true, true>((LAS unsigned char*)lds, g, S, E); }
        { pg8::Gemm g{(const bf16*)(F.ws + WS_O), (const bf16*)(F.ws + WS_WAO), T, D, AW}; pg8::StaticOrder S; S.init(T, D, F.G, (int)blockIdx.x);
          pg8::EpiGateBf16<true> E{(bf16*)(F.ws + WS_MIXED), (const bf16*)(F.ws + WS_GA), D};
          pg8::gemm_phase<pg8::EpiGateBf16<true>, pg8::StaticOrder, true, true>((LAS unsigned char*)lds, g, S, E); }
        if (BOTH(5))  SEAM(); }
    if (IN(6))  {
        pg8::Gemm g{(const bf16*)(F.ws + WS_MIXED), (const bf16*)(F.ws + WS_WMIX), T, D, D}; pg8::StaticOrder S; S.init(T, D, F.G, (int)blockIdx.x);
        pg8::EpiResF32 E{F.out, IN_PTR(0), D, ALPHA};
        pg8::gemm_phase<pg8::EpiResF32, pg8::StaticOrder, true, true>((LAS unsigned char*)lds, g, S, E);
        if (BOTH(6))  SEAM(); }
    if (IN(7))  { if (DUP_PHASE == 7) { ph_ln1_simple(F); SEAM(); } ph_ln1_simple(F);        if (BOTH(7))  SEAM(); }
    if (IN(8))  { ph_router_gemm(F); SEAM(); ph_routing(F); if (BOTH(8))  SEAM(); }
    if (IN(9))  { if (DUP_PHASE == 9) { ph_expert_weights(F); SEAM(); } ph_expert_weights(F);    if (BOTH(9))  SEAM(); }
    if (IN(10)) { ph_up_fast(F);           if (BOTH(10)) SEAM(); }
    if (IN(11)) { ph_down_fast(F);         if (BOTH(11)) SEAM(); }
    if (IN(12)) { if (DUP_PHASE == 12) { ph_final_simple(F); SEAM(); } ph_final_simple(F);      if (BOTH(12)) SEAM(); }
#undef IN
#undef BOTH
}

extern "C" void kernel_launch(void* const* d_in, const int* in_sizes, int n_in, void* d_out, int out_size, void* d_ws, size_t ws_size, hipStream_t stream) {
    static int grid = 0;
    if (grid == 0) {
        if (n_in != 19 || in_sizes[0] != T * D || out_size != T * D || ws_size < WS_END) { fprintf(stderr, "kernel_launch: unexpected shapes / workspace (n_in %d, ws %zu, need %zu); nothing launched\n", n_in, ws_size, (size_t)WS_END); grid = -1; return; }
        int dev = 0, cus = 0, per_cu = 0;
        if (hipGetDevice(&dev) != hipSuccess || hipDeviceGetAttribute(&cus, hipDeviceAttributeMultiprocessorCount, dev) != hipSuccess) { grid = -1; return; }
        if (hipFuncSetAttribute((const void*)fwd_kernel, hipFuncAttributeMaxDynamicSharedMemorySize, LDS_BYTES) != hipSuccess) { fprintf(stderr, "kernel_launch: hipFuncSetAttribute failed\n"); grid = -1; return; }
        if (hipOccupancyMaxActiveBlocksPerMultiprocessor(&per_cu, (const void*)fwd_kernel, NTHR, LDS_BYTES) != hipSuccess || per_cu < 1) { fprintf(stderr, "kernel_launch: occupancy query says %d blocks/CU\n", per_cu); per_cu = 1; }
        (void)hipGetLastError();
        grid = cus;
    }
    if (grid < 0) return;
    (void)hipMemsetAsync((char*)d_ws + WS_CTL, 0, CTL_BYTES, stream);
    Args a{};
    for (int i = 0; i < 19; ++i) a.in[i] = (const float*)d_in[i];
    a.out = (float*)d_out; a.ws = (unsigned char*)d_ws;
#if MK_SINGLE
    a.ph_lo = 0; a.ph_hi = N_PHASES;
    hipLaunchKernelGGL(fwd_kernel, dim3(grid), dim3(NTHR), LDS_BYTES, stream, a);
#else
    for (int p = 0; p < N_PHASES; ++p) { a.ph_lo = p; a.ph_hi = p + 1; hipLaunchKernelGGL(fwd_kernel, dim3(grid), dim3(NTHR), LDS_BYTES, stream, a); }
#endif
}
```
